# Optimizing an MI355X kernel written in HIP

```python
import jax, jax.numpy as jnp
from jax import lax
import numpy as np

D_MODEL = 4096
BATCH = 8
SEQ = 2048
DEPTH = 1
DEC_BATCH = 32
DEC_SEQ = 16
PAST_LEN = 1024

CHUNK = 64
D_BRANCH = D_MODEL // 2
GMLP_CHUNK = 128
GMLP_GROUPS = 8
GMLP_GDIM = D_BRANCH // GMLP_GROUPS
N_HEADS = 16
HEAD_DIM = D_BRANCH // N_HEADS
PAST_CHUNKS = 8
BAND = (PAST_CHUNKS + 1) * CHUNK
WINDOW = PAST_CHUNKS * CHUNK
REL_CLIP = 128
PLE_DIM = 256
EPS = 1e-6
NEG_INF = -1e30

kernel_name = 'hybrid_gmlp_bandattn_stream_step'


def _rmsnorm(x, g):
    xf = x.astype(jnp.float32)
    y = xf * lax.rsqrt(jnp.mean(xf * xf, axis=-1, keepdims=True) + EPS)
    return (y * g.astype(jnp.float32)).astype(x.dtype)


def _layernorm(x, g, b):
    xf = x.astype(jnp.float32)
    xc = xf - jnp.mean(xf, axis=-1, keepdims=True)
    y = xc * lax.rsqrt(jnp.mean(xc * xc, axis=-1, keepdims=True) + EPS)
    return (y * g.astype(jnp.float32) + b.astype(jnp.float32)).astype(x.dtype)


def _chunk_causal_mask(n):
    c = jnp.arange(n) // CHUNK
    return c[None, :] <= c[:, None]


def _rel_bias(rel_bias, d):
    idx = jnp.clip(d, -REL_CLIP, REL_CLIP) + REL_CLIP
    return jnp.take(rel_bias.astype(jnp.float32), idx, axis=1)


def _project_in(x, pre_g, w_in):
    h = _rmsnorm(x, pre_g)
    sizes = [D_BRANCH] * 7 + [D_MODEL] * 2
    offs = [int(o) for o in np.cumsum(sizes)[:-1]]
    return jnp.split(h @ w_in, offs, axis=-1)


def _gmlp_uv(u, v, ln_g, ln_b):
    u = jax.nn.gelu(u, approximate=False)
    vn = _layernorm(jax.nn.gelu(v, approximate=False), ln_g, ln_b)
    return u, vn


def _sgu_prompt(vn, w_s, b_s):
    B, S, _ = vn.shape
    n = S // GMLP_CHUNK
    w = jnp.where(_chunk_causal_mask(GMLP_CHUNK)[None], w_s, 0)
    vg = vn.reshape(B, n, GMLP_CHUNK, GMLP_GROUPS, GMLP_GDIM)
    out = jnp.einsum('gij,bnjgc->bnigc', w, vg) + b_s.T[None, None, :, :, None]
    return out.reshape(B, S, D_BRANCH)


def _sgu_sample(vn, w_s, b_s):
    B, T, _ = vn.shape
    w = jnp.where(_chunk_causal_mask(T)[None], w_s[:, :T, :T], 0)
    vg = vn.reshape(B, T, GMLP_GROUPS, GMLP_GDIM)
    out = jnp.einsum('gij,bjgc->bigc', w, vg) + b_s[:, :T].T[None, :, :, None]
    return out.reshape(B, T, D_BRANCH)


def _band_attention_prompt(q, k, v, rel_bias):
    B, S, H, Dh = q.shape
    n_c = S // CHUNK
    qc = (q * (Dh ** -0.5)).reshape(B, n_c, CHUNK, H, Dh)
    pad = ((0, 0), (WINDOW, 0), (0, 0), (0, 0))
    kc = jnp.pad(k, pad).reshape(B, n_c + PAST_CHUNKS, CHUNK, H, Dh)
    vc = jnp.pad(v, pad).reshape(B, n_c + PAST_CHUNKS, CHUNK, H, Dh)
    scores = jnp.concatenate(
        [jnp.einsum('bcqhd,bckhd->bhcqk', qc, kc[:, s:s + n_c]) for s in range(PAST_CHUNKS + 1)],
        axis=-1).astype(jnp.float32)
    q_off = jnp.arange(CHUNK)
    k_off = jnp.arange(BAND) - WINDOW
    bias = _rel_bias(rel_bias, q_off[:, None] - k_off[None, :])
    valid = (jnp.arange(n_c)[:, None] + (jnp.arange(BAND) // CHUNK)[None, :] - PAST_CHUNKS) >= 0
    scores = jnp.where(valid[None, None, :, None, :], scores + bias[None, :, None], NEG_INF)
    probs = jax.nn.softmax(scores, axis=-1).astype(v.dtype)
    out = jnp.einsum('bhcqk,bckhd->bcqhd', probs[..., :CHUNK], vc[:, 0:n_c])
    for s in range(1, PAST_CHUNKS + 1):
        out = out + jnp.einsum('bhcqk,bckhd->bcqhd',
                               probs[..., s * CHUNK:(s + 1) * CHUNK], vc[:, s:s + n_c])
    return out.reshape(B, S, H, Dh)


def _band_attention_sample(q, k_new, v_new, k_cache, v_cache, rel_bias):
    Dh = q.shape[-1]
    T = q.shape[1]
    Lc = k_cache.shape[1]
    keys = jnp.concatenate([k_cache, k_new], axis=1)
    vals = jnp.concatenate([v_cache, v_new], axis=1)
    scores = jnp.einsum('bqhd,bkhd->bhqk', q * (Dh ** -0.5), keys).astype(jnp.float32)
    k_off = jnp.concatenate([jnp.arange(Lc) - Lc, jnp.arange(T)])
    bias = _rel_bias(rel_bias, jnp.arange(T)[:, None] - k_off[None, :])
    probs = jax.nn.softmax(scores + bias[None], axis=-1).astype(vals.dtype)
    return jnp.einsum('bhqk,bkhd->bqhd', probs, vals)


def _merge_and_residual(x, y_a, y_b, g_a, g_b, w_up_a, w_up_b, w_out, post_g):
    m = jax.nn.sigmoid(g_a) * (y_a @ w_up_a) + jax.nn.sigmoid(g_b) * (y_b @ w_up_b)
    return x + _rmsnorm(m @ w_out, post_g)


def _ple(x, p, w_pg, w_pp):
    return x + jax.nn.sigmoid(x @ w_pg) * (p @ w_pp)


def _prompt_layer(x, p, pre_g, post_g, w_in, ln_g, ln_b, w_s, b_s, rel_bias,
                  w_up_a, w_up_b, w_out, w_pg, w_pp):
    B, S, _ = x.shape
    u, v, z_a, q, k, val, z_b, g_a, g_b = _project_in(x, pre_g, w_in)
    u, vn = _gmlp_uv(u, v, ln_g, ln_b)
    y_a = u * _sgu_prompt(vn, w_s, b_s) * jax.nn.silu(z_a)
    qh = q.reshape(B, S, N_HEADS, HEAD_DIM)
    kh = k.reshape(B, S, N_HEADS, HEAD_DIM)
    vh = val.reshape(B, S, N_HEADS, HEAD_DIM)
    y_b = _band_attention_prompt(qh, kh, vh, rel_bias).reshape(B, S, D_BRANCH) * jax.nn.silu(z_b)
    x = _merge_and_residual(x, y_a, y_b, g_a, g_b, w_up_a, w_up_b, w_out, post_g)
    x = _ple(x, p, w_pg, w_pp)
    keep = min(WINDOW, S)
    return x, kh[:, S - keep:], vh[:, S - keep:], vn[:, S - GMLP_CHUNK:]


def _sample_layer(x, p, k_cache, v_cache, pre_g, post_g, w_in, ln_g, ln_b, w_s, b_s, rel_bias,
                  w_up_a, w_up_b, w_out, w_pg, w_pp):
    B, T, _ = x.shape
    u, v, z_a, q, k, val, z_b, g_a, g_b = _project_in(x, pre_g, w_in)
    u, vn = _gmlp_uv(u, v, ln_g, ln_b)
    y_a = u * _sgu_sample(vn, w_s, b_s) * jax.nn.silu(z_a)
    qh = q.reshape(B, T, N_HEADS, HEAD_DIM)
    kh = k.reshape(B, T, N_HEADS, HEAD_DIM)
    vh = val.reshape(B, T, N_HEADS, HEAD_DIM)
    y_b = _band_attention_sample(qh, kh, vh, k_cache, v_cache, rel_bias).reshape(B, T, D_BRANCH)
    y_b = y_b * jax.nn.silu(z_b)
    x = _merge_and_residual(x, y_a, y_b, g_a, g_b, w_up_a, w_up_b, w_out, post_g)
    x = _ple(x, p, w_pg, w_pp)
    return x, kh, vh, vn


def setup_inputs(seed: int = 0) -> dict:
    key = jax.random.key(seed)
    ks = jax.random.split(key, 20)

    def nrm(k, shape, scale):
        return jax.random.normal(k, shape, jnp.float32) * scale

    cache_len = min(WINDOW, PAST_LEN)
    d_in = 7 * D_BRANCH + 2 * D_MODEL
    return {
        'x_prompt': nrm(ks[0], (BATCH, SEQ, D_MODEL), 1.0),
        'x_sample': nrm(ks[1], (DEC_BATCH, DEC_SEQ, D_MODEL), 1.0),
        'cache_attn_k': nrm(ks[2], (DEPTH, DEC_BATCH, cache_len, N_HEADS, HEAD_DIM), 1.0),
        'cache_attn_v': nrm(ks[3], (DEPTH, DEC_BATCH, cache_len, N_HEADS, HEAD_DIM), 1.0),
        'p_prompt': nrm(ks[4], (DEPTH, BATCH, SEQ, PLE_DIM), 1.0),
        'p_sample': nrm(ks[5], (DEPTH, DEC_BATCH, DEC_SEQ, PLE_DIM), 1.0),
        'norm_pre_g': 1.0 + nrm(ks[6], (DEPTH, D_MODEL), 0.01),
        'norm_post_g': 1.0 + nrm(ks[7], (DEPTH, D_MODEL), 0.01),
        'w_in': nrm(ks[8], (DEPTH, D_MODEL, d_in), D_MODEL ** -0.5),
        'gmlp_ln_g': 1.0 + nrm(ks[9], (DEPTH, D_BRANCH), 0.01),
        'gmlp_ln_b': nrm(ks[10], (DEPTH, D_BRANCH), 0.01),
        'gmlp_w_s': nrm(ks[11], (DEPTH, GMLP_GROUPS, GMLP_CHUNK, GMLP_CHUNK), 0.5 * GMLP_CHUNK ** -0.5),
        'gmlp_b_s': 1.0 + nrm(ks[12], (DEPTH, GMLP_GROUPS, GMLP_CHUNK), 0.01),
        'attn_rel_bias': nrm(ks[13], (DEPTH, N_HEADS, 2 * REL_CLIP + 1), 0.1),
        'w_up_a': nrm(ks[14], (DEPTH, D_BRANCH, D_MODEL), D_BRANCH ** -0.5),
        'w_up_b': nrm(ks[15], (DEPTH, D_BRANCH, D_MODEL), D_BRANCH ** -0.5),
        'w_out': nrm(ks[16], (DEPTH, D_MODEL, D_MODEL), D_MODEL ** -0.5),
        'w_ple_gate': nrm(ks[17], (DEPTH, D_MODEL, D_MODEL), D_MODEL ** -0.5),
        'w_ple_proj': nrm(ks[18], (DEPTH, PLE_DIM, D_MODEL), PLE_DIM ** -0.5),
    }


def reference(x_prompt, x_sample, cache_attn_k, cache_attn_v, p_prompt, p_sample,
              norm_pre_g, norm_post_g, w_in, gmlp_ln_g, gmlp_ln_b, gmlp_w_s, gmlp_b_s,
              attn_rel_bias, w_up_a, w_up_b, w_out, w_ple_gate, w_ple_proj):
    xp = x_prompt
    xs = x_sample
    kp_l, vp_l, ks_l, vs_l, gp_l, gs_l = [], [], [], [], [], []
    for i in range(DEPTH):
        xp, kp, vp, gp = _prompt_layer(
            xp, p_prompt[i], norm_pre_g[i], norm_post_g[i], w_in[i], gmlp_ln_g[i], gmlp_ln_b[i],
            gmlp_w_s[i], gmlp_b_s[i], attn_rel_bias[i], w_up_a[i], w_up_b[i], w_out[i],
            w_ple_gate[i], w_ple_proj[i])
        xs, kn, vn, gn = _sample_layer(
            xs, p_sample[i], cache_attn_k[i], cache_attn_v[i], norm_pre_g[i], norm_post_g[i],
            w_in[i], gmlp_ln_g[i], gmlp_ln_b[i], gmlp_w_s[i], gmlp_b_s[i], attn_rel_bias[i],
            w_up_a[i], w_up_b[i], w_out[i], w_ple_gate[i], w_ple_proj[i])
        kp_l.append(kp)
        vp_l.append(vp)
        ks_l.append(kn)
        vs_l.append(vn)
        gp_l.append(gp)
        gs_l.append(gn)
    new_k_prompt = jnp.stack(kp_l)
    new_v_prompt = jnp.stack(vp_l)
    new_k_sample = jnp.stack(ks_l)
    new_v_sample = jnp.stack(vs_l)
    gmlp_v_prompt = jnp.stack(gp_l)
    gmlp_v_sample = jnp.stack(gs_l)
    return (xp, xs, new_k_prompt, new_v_prompt, new_k_sample, new_v_sample, gmlp_v_prompt, gmlp_v_sample)
```

```cpp
#include <hip/hip_runtime.h>
#include <cstdio>
#include <cstdint>

#ifndef MK_N_LAUNCHES
#define MK_N_LAUNCHES 1
#endif

constexpr int DM = 4096, DBR = 2048, NB = 8, SEQ = 2048, DECB = 32, DECT = 16;
constexpr int MP = NB * SEQ, MS = DECB * DECT, M = MP + MS;
constexpr int NIN = 7 * DBR + 2 * DM;
constexpr int NH = 16, HD = 128, PLE = 256, NGRP = 8, GCH = 128, GDIM = 256, CACHE = 512, NREL = 257;
constexpr float EPS = 1e-6f;
constexpr size_t OFF_Y = 0, OFF_KP = (size_t)M * DM, OFF_VP = OFF_KP + (size_t)NB * 512 * DBR, OFF_KS = OFF_VP + (size_t)NB * 512 * DBR,
                 OFF_VS = OFF_KS + (size_t)MS * DBR, OFF_GP = OFF_VS + (size_t)MS * DBR, OFF_GS = OFF_GP + (size_t)NB * GCH * DBR, OUT_TOTAL = OFF_GS + (size_t)MS * DBR;
constexpr size_t MiB = 1u << 20;
constexpr size_t WS_CTL = 0, CTL_ZERO_BYTES = 1 * MiB;
constexpr size_t WS_WIN = 1 * MiB, WS_WUA = 177 * MiB, WS_WUB = 193 * MiB, WS_WOUT = 209 * MiB, WS_WPG = 241 * MiB, WS_WPP = 273 * MiB, WS_WS = 275 * MiB, WS_PB = 276 * MiB;
constexpr size_t WS_H = 285 * MiB;
constexpr size_t WS_SEG = 417 * MiB;
constexpr size_t SEG2K = (size_t)M * DBR * 2;
constexpr size_t WS_P = 1143 * MiB, WS_SLAB = 1275 * MiB, WS_END = 1339 * MiB;
constexpr size_t WS_MBUF = WS_SEG, WS_T = WS_SEG + 2 * SEG2K, WS_X1B = WS_SEG + 4 * SEG2K;
static_assert(SEG2K == 66 * MiB && WS_SEG + 7 * SEG2K + 4 * SEG2K == WS_P && WS_H + 2 * SEG2K == WS_SEG, "ws map");
constexpr int CW_TMO = 0, CW_BAR = 4096;

#define GAS __attribute__((address_space(1)))
#define LAS __attribute__((address_space(3)))
typedef unsigned short bf16;
typedef unsigned v4u __attribute__((ext_vector_type(4)));
typedef unsigned v2u __attribute__((ext_vector_type(2)));
typedef float f32x4 __attribute__((ext_vector_type(4)));
typedef float f32x2 __attribute__((ext_vector_type(2)));
typedef float f32x16 __attribute__((ext_vector_type(16)));
typedef short bf16x8 __attribute__((ext_vector_type(8)));
typedef short s16x4 __attribute__((ext_vector_type(4)));
typedef GAS unsigned gu32;
#define RLX_AGENT __ATOMIC_RELAXED, __HIP_MEMORY_SCOPE_AGENT
#define LDS_WAIT() asm volatile("s_waitcnt lgkmcnt(0)" ::: "memory")
#define VM_WAIT() asm volatile("s_waitcnt vmcnt(0)" ::: "memory")

typedef __bf16 bf16x2_t __attribute__((ext_vector_type(2)));
__device__ __forceinline__ unsigned cvt_pk_bf16(float lo, float hi) { const f32x2 v = {lo, hi}; return __builtin_bit_cast(unsigned, __builtin_convertvector(v, bf16x2_t)); }
__device__ __forceinline__ float bf_lo(unsigned w) { return __uint_as_float(w << 16); }
__device__ __forceinline__ float bf_hi(unsigned w) { return __uint_as_float(w & 0xffff0000u); }
__device__ __forceinline__ float bf2f(bf16 b) { return __uint_as_float(((unsigned)b) << 16); }
__device__ __forceinline__ float sigmoid_f(float v) { return __builtin_amdgcn_rcpf(1.0f + __builtin_amdgcn_exp2f(-1.4426950408889634f * v)); }
__device__ __forceinline__ float silu_f(float v) { return v * sigmoid_f(v); }
__device__ __forceinline__ f32x2 gelu_pk(f32x2 v) {
    const f32x2 av = __builtin_elementwise_abs(v), d = av * 0.2316418882f + 1.0f;
    f32x2 t; t.x = __builtin_amdgcn_rcpf(d.x); t.y = __builtin_amdgcn_rcpf(d.y);
    f32x2 q = t * 0.5307027145f + (-0.7265760135f); q = q * t + 0.7107068705f; q = q * t + (-0.142248368f); q = q * t + 0.127414796f; q = q * t;
    const f32x2 s = (v * v) * (-0.72134752044f);
    f32x2 e; e.x = __builtin_amdgcn_exp2f(s.x); e.y = __builtin_amdgcn_exp2f(s.y);
    const f32x2 m = v * (q * e), r = v - m;
    f32x2 o; o.x = v.x < 0.f ? m.x : r.x; o.y = v.y < 0.f ? m.y : r.y; return o;
}
__device__ __forceinline__ float wave_sum(float v) {
#pragma unroll
    for (int o = 1; o < 64; o <<= 1) v += __shfl_xor(v, o);
    return v;
}

namespace pg8 {
#define PG8_LAS __attribute__((address_space(3)))
typedef unsigned short bf16_t;
constexpr int BM = 256, BK = 64, HALF = 128, HTB = HALF * BK * 2, STAGE_BYTES = 8 * HTB, NXCD = 8, WGM = 8;
__host__ __device__ __forceinline__ int lds_byte(int r, int c) { const int st = (r >> 4) * 2 + (c >> 5), rr = r & 15, cc = c & 31, ob = rr * 64 + cc * 2; return st * 1024 + (ob ^ (((ob >> 9) & 1) << 5)); }
__host__ __device__ __forceinline__ void stage_rc(int b, int& R, int& C) { const int st = b / 1024, sb = b % 1024, swz = sb ^ (((sb >> 9) & 1) << 5); R = (st >> 1) * 16 + swz / 64; C = (st & 1) * 32 + (swz % 64) / 2; }
__host__ __device__ __forceinline__ int perm32(int rho) { const int n = rho >> 4, i = rho & 15; return 8 * (i >> 2) + 4 * n + (i & 3); }

struct Unit { int pm, pn, seg, kind, ks, nt; const char* a; const char* b; };
struct Order {
    const bf16_t *A, *Bt, *A2, *Bt2; int lda, ldb;
    int nMf, nN, nfull, G, c, nseg, ntf, nsub, nslice, nts, pm_sub0, nf_c, sub_first = 0;
    __device__ void init(const bf16_t* A_, const bf16_t* Bt_, const bf16_t* A2_, const bf16_t* Bt2_, int lda_, int ldb_, int Mfull, int N_, int Kseg, int nseg_, int G_, int c_, int Msub, int nslice_, int pm_sub0_) {
        A = A_; Bt = Bt_; A2 = A2_; Bt2 = Bt2_; lda = lda_; ldb = ldb_; nMf = Mfull / BM; nN = N_ / BM; nfull = nMf * nN; G = G_; c = c_; nseg = nseg_; ntf = Kseg / BK;
        nslice = nslice_; nsub = (Msub / BM) * nN * nslice_; nts = nslice_ ? (Kseg * nseg_ / nslice_) / BK : 0; pm_sub0 = pm_sub0_;
        nf_c = (c < nfull) ? (nfull - c + G - 1) / G : 0;
    }
    __device__ bool next(int i_, Unit& u) const {
        int i = i_; const size_t tA = (size_t)BM * lda * 2, tB = (size_t)BM * ldb * 2;
        const int ns_c = (c < nsub) ? (nsub - c + G - 1) / G : 0;
        if (sub_first) { if (i_ < ns_c) i = nf_c * nseg + i_; else { i = i_ - ns_c; if (i >= nf_c * nseg) return false; } }
        if (i < nf_c * nseg) {
            const int r = (nseg == 2) ? (i >> 1) : i; u.seg = (nseg == 2) ? (i & 1) : 0; u.kind = 0; u.ks = 0; u.nt = ntf;
            int wgid = r * G + c; { const int q = nfull / NXCD, rr = nfull % NXCD, xcd = wgid % NXCD, off = wgid / NXCD; wgid = (xcd < rr ? xcd * (q + 1) : rr * (q + 1) + (xcd - rr) * q) + off; }
            const int nig = WGM * nN, gid = wgid / nig, fm = gid * WGM, gsz = (nMf - fm) < WGM ? (nMf - fm) : WGM;
            u.pm = fm + ((wgid % nig) % gsz); u.pn = (wgid % nig) / gsz;
            u.a = (const char*)(u.seg ? A2 : A) + (size_t)u.pm * tA; u.b = (const char*)(u.seg ? Bt2 : Bt) + (size_t)u.pn * tB; return true;
        }
        const long sidx = (long)(nf_c + (i - nf_c * nseg)) * G + c - nfull;
        if (sidx >= nsub) return false;
        const int s = (int)sidx, ks = s % nslice, tile = s / nslice, sps = nslice / nseg;
        u.kind = 1; u.ks = ks; u.nt = nts; u.pn = tile % nN; u.pm = pm_sub0 + tile / nN; u.seg = ks / sps;
        const size_t kofs = (size_t)(ks % sps) * nts * BK * 2;
        u.a = (const char*)(u.seg ? A2 : A) + (size_t)u.pm * tA + kofs; u.b = (const char*)(u.seg ? Bt2 : Bt) + (size_t)u.pn * tB + kofs; return true;
    }
};

template <class Epi, bool ALIGN_EPI = true>
__device__ __forceinline__ void gemm_phase(PG8_LAS unsigned char* lds, const Order& S, const Epi& E) {
    const int tid = threadIdx.x, wid = __builtin_amdgcn_readfirstlane(tid >> 6), lane = tid & 63, wr = wid >> 2, wc = wid & 3, fr = lane & 15, fq = lane >> 4;
    unsigned voffA[2], voffB[2];
#pragma unroll
    for (int i = 0; i < 2; ++i) { int R, C; stage_rc(tid * 16 + i * 8192, R, C); const int Rb = Epi::PERM ? ((R & ~31) + perm32(R & 31)) : R;
        voffA[i] = (unsigned)(R * S.lda + C) * 2u; voffB[i] = (unsigned)(Rb * S.ldb + C) * 2u; }
    const size_t kstep = (size_t)(BK * 2);
    const size_t hstepA = (size_t)HALF * S.lda * 2, hstepB = (size_t)HALF * S.ldb * 2;
    const unsigned ldsw = (unsigned)wid * 1024u;
    const int aoff = lds_byte(wr * 64 + fr, fq * 8), boff = lds_byte(wc * 32 + fr, fq * 8);
#define PG8_SA(b, h) (((b) * 2 + (h)) * HTB)
#define PG8_SB(b, h) ((4 + (b) * 2 + (h)) * HTB)
#define PG8_STAGE(bufoff, gbase, voff) do { _Pragma("unroll") for (int _i = 0; _i < 2; ++_i) \
        __builtin_amdgcn_global_load_lds((const unsigned*)((const char*)(gbase) + (voff)[_i]), (PG8_LAS unsigned*)(lds + (bufoff) + ldsw + _i * 8192), 16, 0, 0); } while (0)
#define PG8_LDA(dst, b, h) do { _Pragma("unroll") for (int m = 0; m < 4; ++m) _Pragma("unroll") for (int k = 0; k < 2; ++k) dst[m][k] = *(const PG8_LAS bf16x8*)(lds + PG8_SA(b, h) + aoff + m * 2048 + k * 1024); } while (0)
#define PG8_LDB(dst, b, h) do { _Pragma("unroll") for (int n = 0; n < 2; ++n) _Pragma("unroll") for (int k = 0; k < 2; ++k) dst[n][k] = *(const PG8_LAS bf16x8*)(lds + PG8_SB(b, h) + boff + n * 2048 + k * 1024); } while (0)
#define PG8_MMA(ai, bj, At, Bt) do { __builtin_amdgcn_sched_barrier(0); __builtin_amdgcn_s_setprio(1); _Pragma("unroll") for (int m = 0; m < 4; ++m) _Pragma("unroll") for (int n = 0; n < 2; ++n) _Pragma("unroll") for (int k = 0; k < 2; ++k) \
        acc[ai][bj][m][n] = __builtin_amdgcn_mfma_f32_16x16x32_bf16(Bt[n][k], At[m][k], acc[ai][bj][m][n], 0, 0, 0); __builtin_amdgcn_s_setprio(0); __builtin_amdgcn_sched_barrier(0); } while (0)
#define PG8_WAIT_V(n) asm volatile("s_waitcnt vmcnt(" #n ")" ::: "memory")
#define PG8_WAIT_L(n) asm volatile("s_waitcnt lgkmcnt(" #n ")" ::: "memory")
#define PG8_BAR __builtin_amdgcn_s_barrier()
#define PG8_SCHED __builtin_amdgcn_sched_barrier(0)
    Unit cur, nxt; int ui = 0;
    if (!S.next(0, cur)) return;
    f32x4 acc[2][2][4][2];
#pragma unroll
    for (int a = 0; a < 2; ++a)
#pragma unroll
        for (int b = 0; b < 2; ++b)
#pragma unroll
            for (int m = 0; m < 4; ++m)
#pragma unroll
                for (int n = 0; n < 2; ++n) acc[a][b][m][n] = (f32x4){0.f, 0.f, 0.f, 0.f};
    bf16x8 At[4][2], B0[2][2], B1[2][2];
    const char* cA = cur.a; const char* cB = cur.b;
    const int xr = S.c & 7;
#define PG8_ROTB(nt_) ((size_t)((((xr * (nt_)) >> 3) & ~1)) * kstep)
    size_t rb = PG8_ROTB(cur.nt);
    PG8_STAGE(PG8_SB(0, 0), cB + rb, voffB); PG8_STAGE(PG8_SB(0, 1), cB + rb + hstepB, voffB); PG8_STAGE(PG8_SA(0, 0), cA + rb, voffA); PG8_STAGE(PG8_SA(0, 1), cA + rb + hstepA, voffA);
    if (wr == 1) PG8_BAR;
    PG8_WAIT_V(2); PG8_BAR;
    PG8_STAGE(PG8_SB(1, 0), cB + rb + kstep, voffB); PG8_STAGE(PG8_SA(1, 0), cA + rb + kstep, voffA); PG8_STAGE(PG8_SB(1, 1), cB + rb + hstepB + kstep, voffB);
    PG8_WAIT_V(6); PG8_BAR;
    for (;;) {
        const bool has_next = S.next(ui + 1, nxt);
        const char* nA = has_next ? nxt.a : cA; const char* nB = has_next ? nxt.b : cB;
        const int nt = cur.nt;
        const size_t kmask = (size_t)nt * kstep - 1, nrb = has_next ? PG8_ROTB(nxt.nt) : rb;
        for (int t = 0; t < nt; t += 2) {
            const bool last = (t == nt - 2);
            const size_t o1 = ((size_t)(t + 1) * kstep + rb) & kmask, o2 = ((size_t)(t + 2) * kstep + rb) & kmask;
            const char* a1 = cA + o1;
            const char* a2 = last ? nA + nrb : cA + o2; const char* b2 = last ? nB + nrb : cB + o2;
            const char* a3 = a2 + kstep; const char* b3 = b2 + kstep;
            PG8_LDB(B0, 0, 0); PG8_LDB(B1, 0, 1); PG8_SCHED; PG8_LDA(At, 0, 0); PG8_STAGE(PG8_SA(1, 1), a1 + hstepA, voffA);
            PG8_WAIT_V(8); PG8_WAIT_L(0); PG8_BAR; PG8_MMA(0, 0, At, B0); PG8_MMA(0, 1, At, B1); PG8_BAR; PG8_SCHED;
            PG8_LDA(At, 0, 1); PG8_STAGE(PG8_SB(0, 0), b2, voffB); PG8_STAGE(PG8_SB(0, 1), b2 + hstepB, voffB); PG8_STAGE(PG8_SA(0, 0), a2, voffA);
            PG8_WAIT_V(8); PG8_WAIT_L(0); PG8_BAR; PG8_MMA(1, 0, At, B0); PG8_MMA(1, 1, At, B1); PG8_BAR; PG8_SCHED;
            PG8_LDB(B0, 1, 0); PG8_LDB(B1, 1, 1); PG8_SCHED; PG8_LDA(At, 1, 0); PG8_STAGE(PG8_SA(0, 1), a2 + hstepA, voffA);
            PG8_WAIT_V(8); PG8_WAIT_L(0); PG8_BAR; PG8_MMA(0, 0, At, B0); PG8_MMA(0, 1, At, B1); PG8_BAR; PG8_SCHED;
            PG8_LDA(At, 1, 1); PG8_STAGE(PG8_SB(1, 0), b3, voffB); PG8_STAGE(PG8_SB(1, 1), b3 + hstepB, voffB); PG8_STAGE(PG8_SA(1, 0), a3, voffA);
            PG8_WAIT_V(8); PG8_WAIT_L(0); PG8_BAR; PG8_MMA(1, 0, At, B0); PG8_MMA(1, 1, At, B1); PG8_BAR; PG8_SCHED;
        }
        if (ALIGN_EPI) { if (wr == 0) PG8_BAR; }
        E(acc, cur, wr, wc, fr, fq);
        if (!has_next) break;
        if (!(Epi::TWOSEG && nxt.seg == 1)) {
#pragma unroll
        for (int a = 0; a < 2; ++a)
#pragma unroll
            for (int b = 0; b < 2; ++b)
#pragma unroll
                for (int m = 0; m < 4; ++m)
#pragma unroll
                    for (int n = 0; n < 2; ++n) acc[a][b][m][n] = (f32x4){0.f, 0.f, 0.f, 0.f};
        }
        cur = nxt; cA = nA; cB = nB; rb = nrb; ++ui;
        if (ALIGN_EPI) { if (wr == 1) PG8_BAR; }
    }
    PG8_WAIT_V(0);
    if (!ALIGN_EPI) { if (wr == 0) PG8_BAR; }
    PG8_BAR;
#undef PG8_ROTB
#undef PG8_SA
#undef PG8_SB
#undef PG8_STAGE
#undef PG8_LDA
#undef PG8_LDB
#undef PG8_MMA
#undef PG8_WAIT_V
#undef PG8_WAIT_L
#undef PG8_BAR
#undef PG8_SCHED
}

template <bool PERM_>
__device__ __forceinline__ void slab_store(const f32x4 (&acc)[2][2][4][2], const Unit& u, int wr, int wc, int fr, int fq, bf16_t* slab, int pm_sub0, const bf16_t* Gt, const bf16_t* Gt2 = nullptr) {
    const int rloc = (u.pm - pm_sub0) * BM + wr * 64 + fr, grow = u.pm * BM + wr * 64 + fr;
    bf16_t* sb = slab + (size_t)u.ks * (512 * DM);
#pragma unroll
    for (int ai = 0; ai < 2; ++ai)
#pragma unroll
        for (int m = 0; m < 4; ++m) {
#pragma unroll
            for (int bj = 0; bj < 2; ++bj) {
                if (PERM_) { const int col = u.pn * BM + bj * HALF + wc * 32 + 8 * fq; f32x4 v0 = acc[ai][bj][m][0], v1 = acc[ai][bj][m][1];
                    if (Gt) { const v4u b = *(const v4u*)(Gt + (size_t)(grow + ai * HALF + m * 16) * DM + col); v0 *= (f32x4){bf_lo(b.x), bf_hi(b.x), bf_lo(b.y), bf_hi(b.y)}; v1 *= (f32x4){bf_lo(b.z), bf_hi(b.z), bf_lo(b.w), bf_hi(b.w)}; }
                    if (Gt2) { const v4u b = *(const v4u*)(Gt2 + (size_t)(grow + ai * HALF + m * 16) * DM + col); v0 *= (f32x4){bf_lo(b.x), bf_hi(b.x), bf_lo(b.y), bf_hi(b.y)}; v1 *= (f32x4){bf_lo(b.z), bf_hi(b.z), bf_lo(b.w), bf_hi(b.w)}; }
                    v4u w; w.x = cvt_pk_bf16(v0[0], v0[1]); w.y = cvt_pk_bf16(v0[2], v0[3]); w.z = cvt_pk_bf16(v1[0], v1[1]); w.w = cvt_pk_bf16(v1[2], v1[3]);
                    *(v4u*)(sb + (size_t)(rloc + ai * HALF + m * 16) * DM + col) = w; }
                else {
#pragma unroll
                    for (int n = 0; n < 2; ++n) { const int col = u.pn * BM + bj * HALF + wc * 32 + 16 * n + 4 * fq; const f32x4 v = acc[ai][bj][m][n];
                        v2u w; w.x = cvt_pk_bf16(v[0], v[1]); w.y = cvt_pk_bf16(v[2], v[3]); *(v2u*)(sb + (size_t)(rloc + ai * HALF + m * 16) * DM + col) = w; } }
            }
            asm volatile("" ::: "memory"); }
}
struct EpiStore {
    static constexpr bool PERM = true, TWOSEG = false;
    bf16_t* O; int ldc; bf16_t* slab; int pm_sub0;
    __device__ __forceinline__ void operator()(f32x4 (&acc)[2][2][4][2], const Unit& u, int wr, int wc, int fr, int fq) const {
        if (u.kind == 1) { slab_store<true>(acc, u, wr, wc, fr, fq, slab, pm_sub0, nullptr); return; }
        const int row0 = u.pm * BM + wr * 64 + fr, col0 = u.pn * BM + wc * 32 + 8 * fq;
#pragma unroll
        for (int ai = 0; ai < 2; ++ai)
#pragma unroll
            for (int m = 0; m < 4; ++m) { bf16_t* rowp = O + (size_t)(row0 + ai * HALF + m * 16) * ldc + col0;
#pragma unroll
                for (int bj = 0; bj < 2; ++bj) { const f32x4 v0 = acc[ai][bj][m][0], v1 = acc[ai][bj][m][1];
                    v4u w; w.x = cvt_pk_bf16(v0[0], v0[1]); w.y = cvt_pk_bf16(v0[2], v0[3]); w.z = cvt_pk_bf16(v1[0], v1[1]); w.w = cvt_pk_bf16(v1[2], v1[3]);
                    *(v4u*)(rowp + bj * HALF) = w; } }
    }
};
struct EpiIn {
    static constexpr bool PERM = true, TWOSEG = false;
    bf16_t* seg0; float* out;
    template <int ACT, bool F32OUT>
    __device__ __forceinline__ void run(const f32x4 (&acc)[2][2][4][2], bf16_t* O, int ldc, int row0, int col0, float* fo) const {
#pragma unroll
        for (int ai = 0; ai < 2; ++ai)
#pragma unroll
            for (int m = 0; m < 4; ++m) { bf16_t* rowp = O + (size_t)(row0 + ai * HALF + m * 16) * ldc + col0;
#pragma unroll
                for (int bj = 0; bj < 2; ++bj) { f32x4 v0 = acc[ai][bj][m][0], v1 = acc[ai][bj][m][1];
                    if (F32OUT) { float* fp = fo + (size_t)(ai * HALF + m * 16) * DBR + bj * HALF; *(f32x4*)fp = v0; *(f32x4*)(fp + 4) = v1; }
                    if (ACT == 1) { f32x2 a = gelu_pk((f32x2){v0[0], v0[1]}), b = gelu_pk((f32x2){v0[2], v0[3]}), c = gelu_pk((f32x2){v1[0], v1[1]}), d = gelu_pk((f32x2){v1[2], v1[3]});
                        v0 = (f32x4){a.x, a.y, b.x, b.y}; v1 = (f32x4){c.x, c.y, d.x, d.y}; }
                    if (ACT == 2) {
#pragma unroll
                        for (int j = 0; j < 4; ++j) { v0[j] = silu_f(v0[j]); v1[j] = silu_f(v1[j]); } }
                    if (ACT == 3) {
#pragma unroll
                        for (int j = 0; j < 4; ++j) { v0[j] = sigmoid_f(v0[j]); v1[j] = sigmoid_f(v1[j]); } }
                    v4u w; w.x = cvt_pk_bf16(v0[0], v0[1]); w.y = cvt_pk_bf16(v0[2], v0[3]); w.z = cvt_pk_bf16(v1[0], v1[1]); w.w = cvt_pk_bf16(v1[2], v1[3]);
                    *(v4u*)(rowp + bj * HALF) = w; } }
    }
    template <int KIND  >
    __device__ __forceinline__ void run_pair(const f32x4 (&acc)[2][2][4][2], bf16_t* O1, bf16_t* O2, int ldc, int row0, int ch0) const {
#pragma unroll
        for (int ai = 0; ai < 2; ++ai)
#pragma unroll
            for (int m = 0; m < 4; ++m) { const size_t ro = (size_t)(row0 + ai * HALF + m * 16) * ldc + ch0;
#pragma unroll
                for (int bj = 0; bj < 2; ++bj) { const f32x4 v0 = acc[ai][bj][m][0], v1 = acc[ai][bj][m][1];
                    if (KIND == 0) { const f32x2 a = gelu_pk((f32x2){v0[0], v0[1]}), b = gelu_pk((f32x2){v0[2], v0[3]});
                        v2u w; w.x = cvt_pk_bf16(a.x * silu_f(v1[0]), a.y * silu_f(v1[1])); w.y = cvt_pk_bf16(b.x * silu_f(v1[2]), b.y * silu_f(v1[3]));
                        *(v2u*)(O1 + ro + bj * (HALF / 2)) = w; }
                    else { float r[4], sb[4];
#pragma unroll
                        for (int j = 0; j < 4; ++j) { const float ea = __builtin_amdgcn_exp2f(-1.4426950408889634f * v0[j]), eb = __builtin_amdgcn_exp2f(-1.4426950408889634f * v1[j]);
                            sb[j] = __builtin_amdgcn_rcpf(1.0f + eb); r[j] = (1.0f + eb) * __builtin_amdgcn_rcpf(1.0f + ea); }
                        v2u w1, w2; w1.x = cvt_pk_bf16(r[0], r[1]); w1.y = cvt_pk_bf16(r[2], r[3]); w2.x = cvt_pk_bf16(sb[0], sb[1]); w2.y = cvt_pk_bf16(sb[2], sb[3]);
                        *(v2u*)(O1 + ro + bj * (HALF / 2)) = w1; *(v2u*)(O2 + ro + bj * (HALF / 2)) = w2; } } }
    }
    __device__ __forceinline__ void operator()(f32x4 (&acc)[2][2][4][2], const Unit& u, int wr, int wc, int fr, int fq) const {
        const int pn = u.pn, rloc = wr * 64 + fr, row0 = u.pm * BM + rloc;
        if (pn >= 56) { const int ch0 = (pn - 56) * HALF + wc * 16 + 4 * fq;
            run_pair<1>(acc, seg0 + (size_t)7 * M * DBR, seg0 + (size_t)7 * M * DBR + (size_t)M * DM, DM, row0, ch0); return; }
        if (pn < 16) { run_pair<0>(acc, seg0, nullptr, DBR, row0, pn * HALF + wc * 16 + 4 * fq); return; }
        if (pn < 24) { run<1, false>(acc, seg0 + (size_t)M * DBR, DBR, row0, (pn - 16) * BM + wc * 32 + 8 * fq, nullptr); return; }
        const int s = pn >> 3, col0 = (pn & 7) * BM + wc * 32 + 8 * fq; bf16_t* O = seg0 + (size_t)s * M * DBR;
        if (s == 6) { run<2, false>(acc, O, DBR, row0, col0, nullptr); return; }
        if (s == 3) { run<0, false>(acc, O, DBR, row0, col0, nullptr); return; }
        const int pm = u.pm; float* fo = nullptr;
        if (pm >= 64) fo = out + (s == 4 ? OFF_KS : OFF_VS) + (size_t)((pm - 64) * BM + rloc) * DBR + col0;
        else if ((pm & 7) >= 6) fo = out + (s == 4 ? OFF_KP : OFF_VP) + (size_t)((pm >> 3) * 512 + ((pm & 7) - 6) * BM + rloc) * DBR + col0;
        if (fo) run<0, true>(acc, O, DBR, row0, col0, fo); else run<0, false>(acc, O, DBR, row0, col0, nullptr);
    }
};
struct EpiMerge {
    static constexpr bool PERM = true, TWOSEG = true;
    const bf16_t* SGA; const bf16_t* SGB; bf16_t* O;
    __device__ __forceinline__ void operator()(f32x4 (&acc)[2][2][4][2], const Unit& u, int wr, int wc, int fr, int fq) const {
        const int row0 = u.pm * BM + wr * 64 + fr, col0 = u.pn * BM + wc * 32 + 8 * fq;
#define MG_OFF(it) ((size_t)(row0 + ((it) >> 2) * HALF + ((it) & 3) * 16) * DM + col0)
        if (u.seg == 0) {
            v4u ga[2][2];
            { const size_t off = MG_OFF(0); ga[0][0] = *(const v4u*)(SGA + off); ga[0][1] = *(const v4u*)(SGA + off + HALF); }
#pragma unroll
            for (int it = 0; it < 8; ++it) { const int ai = it >> 2, m = it & 3, cb = it & 1, nb = cb ^ 1;
                if (it + 1 < 8) { const size_t off = MG_OFF(it + 1); ga[nb][0] = *(const v4u*)(SGA + off); ga[nb][1] = *(const v4u*)(SGA + off + HALF); }
                asm volatile("" ::: "memory");
#pragma unroll
                for (int bj = 0; bj < 2; ++bj) { const v4u a = ga[cb][bj];
                    acc[ai][bj][m][0] *= (f32x4){bf_lo(a.x), bf_hi(a.x), bf_lo(a.y), bf_hi(a.y)}; acc[ai][bj][m][1] *= (f32x4){bf_lo(a.z), bf_hi(a.z), bf_lo(a.w), bf_hi(a.w)}; }
                asm volatile("" ::: "memory"); }
        } else {
            v4u gb[2][2];
            { const size_t off = MG_OFF(0); gb[0][0] = *(const v4u*)(SGB + off); gb[0][1] = *(const v4u*)(SGB + off + HALF); }
#pragma unroll
            for (int it = 0; it < 8; ++it) { const int ai = it >> 2, m = it & 3, cb = it & 1, nb = cb ^ 1;
                if (it + 1 < 8) { const size_t off = MG_OFF(it + 1); gb[nb][0] = *(const v4u*)(SGB + off); gb[nb][1] = *(const v4u*)(SGB + off + HALF); }
                asm volatile("" ::: "memory");
                const size_t off = MG_OFF(it);
#pragma unroll
                for (int bj = 0; bj < 2; ++bj) { const v4u b = gb[cb][bj];
                    const f32x4 v0 = acc[ai][bj][m][0] * (f32x4){bf_lo(b.x), bf_hi(b.x), bf_lo(b.y), bf_hi(b.y)}, v1 = acc[ai][bj][m][1] * (f32x4){bf_lo(b.z), bf_hi(b.z), bf_lo(b.w), bf_hi(b.w)};
                    v4u w; w.x = cvt_pk_bf16(v0[0], v0[1]); w.y = cvt_pk_bf16(v0[2], v0[3]); w.z = cvt_pk_bf16(v1[0], v1[1]); w.w = cvt_pk_bf16(v1[2], v1[3]);
                    *(v4u*)(O + off + bj * HALF) = w; }
                asm volatile("" ::: "memory"); }
        }
#undef MG_OFF
    }
};
struct EpiMergeSub {
    static constexpr bool PERM = true, TWOSEG = false;
    const bf16_t* SGA; const bf16_t* SGB; bf16_t* slab; int pm_sub0;
    __device__ __forceinline__ void operator()(f32x4 (&acc)[2][2][4][2], const Unit& u, int wr, int wc, int fr, int fq) const {
        slab_store<true>(acc, u, wr, wc, fr, fq, slab, pm_sub0, SGB, u.seg ? nullptr : SGA);
    }
};
struct EpiFinal {
    static constexpr bool PERM = false, TWOSEG = false;
    float* Y; const bf16_t* P; bf16_t* slab; int pm_sub0; const bf16_t* XB;
    __device__ __forceinline__ void operator()(f32x4 (&acc)[2][2][4][2], const Unit& u, int wr, int wc, int fr, int fq) const {
        if (u.kind == 1) { slab_store<false>(acc, u, wr, wc, fr, fq, slab, pm_sub0, nullptr); return; }
        const int row0 = u.pm * BM + wr * 64 + fr, col0 = u.pn * BM + wc * 32 + 4 * fq;
#define FN_OFF(it) ((size_t)(row0 + ((it) >> 2) * HALF + ((it) & 3) * 16) * DM + col0)
        v2u xv[2][4], pv[2][4];
        { const size_t off = FN_OFF(0);
#pragma unroll
          for (int q = 0; q < 4; ++q) { const size_t o2 = off + (q >> 1) * HALF + (q & 1) * 16; xv[0][q] = *(const v2u*)(XB + o2); pv[0][q] = *(const v2u*)(P + o2); } }
#pragma unroll
        for (int it = 0; it < 8; ++it) { const int ai = it >> 2, m = it & 3, cb = it & 1, nb = cb ^ 1;
            if (it + 1 < 8) { const size_t off = FN_OFF(it + 1);
#pragma unroll
                for (int q = 0; q < 4; ++q) { const size_t o2 = off + (q >> 1) * HALF + (q & 1) * 16; xv[nb][q] = *(const v2u*)(XB + o2); pv[nb][q] = *(const v2u*)(P + o2); } }
            asm volatile("" ::: "memory");
            const size_t off = FN_OFF(it);
#pragma unroll
            for (int q = 0; q < 4; ++q) { const int bj = q >> 1, n = q & 1; const size_t o2 = off + bj * HALF + n * 16; const v2u x1 = xv[cb][q], p = pv[cb][q]; const f32x4 a = acc[ai][bj][m][n];
                f32x4 y; y[0] = bf_lo(x1.x) + sigmoid_f(a[0]) * bf_lo(p.x); y[1] = bf_hi(x1.x) + sigmoid_f(a[1]) * bf_hi(p.x); y[2] = bf_lo(x1.y) + sigmoid_f(a[2]) * bf_lo(p.y); y[3] = bf_hi(x1.y) + sigmoid_f(a[3]) * bf_hi(p.y);
                *(f32x4*)(Y + o2) = y; }
            asm volatile("" ::: "memory"); }
#undef FN_OFF
    }
};
}

namespace att {
constexpr float SCALE = 0.08838834764831845f, THR = 8.f;
constexpr int SHM = 16384;
constexpr int OFF_V = 0, OFF_K = 2 * SHM, OFF_TAB = 4 * SHM, OFF_WS = 4 * SHM + 2048, LDS_NEED = OFF_WS + 8 * 256;
#define KSWZ(row, colB) ((row) * 256 + ((colB) ^ (((row) & 7) << 4)))
#define SBAR() __builtin_amdgcn_sched_barrier(0)
__device__ __forceinline__ int v_st(int k, int c) { const int kk = (k & ~0xC) | ((k & 4) << 1) | ((k & 8) >> 1); return ((kk >> 3) * 4 + (c >> 5)) * 512 + ((kk & 7) * 32 + (c & 31)) * 2; }
__device__ __forceinline__ int v_rd_base(int lane) { return ((lane & 3) << 3) | (((lane >> 2) & 3) << 6) | (((lane >> 4) & 1) << 5) | (((lane >> 5) & 1) << 8); }
constexpr int v_rd_off(int d0, int ks, int half) { return d0 * 512 + ks * 4096 + half * 2048; }
__device__ __forceinline__ int crow(int r, int hi) { return (r & 3) + 8 * (r >> 2) + 4 * hi; }
__device__ __forceinline__ void partialSM(f32x16& p0, f32x16& p1, float& m_reg, float& mn, float& alpha) {
    float pmax = p0[0];
#pragma unroll
    for (int r = 1; r < 16; ++r) pmax = fmaxf(pmax, p0[r]);
#pragma unroll
    for (int r = 0; r < 16; ++r) pmax = fmaxf(pmax, p1[r]);
    { auto rr = __builtin_amdgcn_permlane32_swap(__float_as_uint(pmax), __float_as_uint(pmax), false, false);
      pmax = fmaxf(__uint_as_float(rr[0]), __uint_as_float(rr[1])); }
    constexpr float C2 = 1.4426950408889634f * SCALE;
    if (__builtin_expect(__all((pmax - m_reg) * SCALE <= THR), 1)) { mn = m_reg; alpha = 1.f; }
    else { mn = fmaxf(m_reg, pmax); alpha = __builtin_amdgcn_exp2f((m_reg - mn) * C2); m_reg = mn; }
    const float mnL = -mn * C2;
#pragma unroll
    for (int r = 0; r < 16; ++r) p0[r] = fmaf(p0[r], C2, mnL);
#pragma unroll
    for (int r = 0; r < 16; ++r) p1[r] = fmaf(p1[r], C2, mnL);
#pragma unroll
    for (int r = 0; r < 16; ++r) p0[r] = __builtin_amdgcn_exp2f(p0[r]);
}
__device__ __forceinline__ void finishSM(f32x16& p0, f32x16& p1, float alpha, float& l_reg, bf16x8& pa0, bf16x8& pa1, bf16x8& pa2, bf16x8& pa3) {
#pragma unroll
    for (int r = 0; r < 16; ++r) p1[r] = __builtin_amdgcn_exp2f(p1[r]);
    float ps = 0;
#pragma unroll
    for (int r = 0; r < 16; ++r) ps += p0[r];
#pragma unroll
    for (int r = 0; r < 16; ++r) ps += p1[r];
    { auto rr = __builtin_amdgcn_permlane32_swap(__float_as_uint(ps), __float_as_uint(ps), false, false);
      ps = __uint_as_float(rr[0]) + __uint_as_float(rr[1]); }
    l_reg = l_reg * alpha + ps;
#define PK4(P, B_, OUT) do { unsigned a0 = cvt_pk_bf16(P[B_+0], P[B_+1]), a1 = cvt_pk_bf16(P[B_+2], P[B_+3]);                          \
        unsigned b0 = cvt_pk_bf16(P[B_+4], P[B_+5]), b1 = cvt_pk_bf16(P[B_+6], P[B_+7]);                                             \
        auto r0 = __builtin_amdgcn_permlane32_swap(a0, b0, false, false); auto r1 = __builtin_amdgcn_permlane32_swap(a1, b1, false, false); \
        v4u w = {r0[0], r1[0], r0[1], r1[1]}; OUT = *reinterpret_cast<bf16x8*>(&w); } while (0)
    PK4(p0, 0, pa0); PK4(p0, 8, pa1); PK4(p1, 0, pa2); PK4(p1, 8, pa3);
#undef PK4
}
template <int KB>
__device__ __forceinline__ void qkt(f32x16& p0, f32x16& p1, const char* K_lds, int r32, int hi, const bf16x8* qr) {
    const char* kb[4];
#pragma unroll
    for (int dd = 0; dd < 4; ++dd) kb[dd] = K_lds + KB * SHM + KSWZ(r32, (dd * 16 + hi * 8) * 2);
#pragma unroll
    for (int hf = 0; hf < 2; ++hf) {
        bf16x8 f0[4], f1[4];
#pragma unroll
        for (int dd = 0; dd < 4; ++dd) { const char* a = kb[dd] + hf * 128; f0[dd] = *reinterpret_cast<const bf16x8*>(a); f1[dd] = *reinterpret_cast<const bf16x8*>(a + 32 * 256); }
        asm volatile("s_waitcnt lgkmcnt(0)" ::: "memory"); SBAR();
#pragma unroll
        for (int dd = 0; dd < 4; ++dd) { p0 = __builtin_amdgcn_mfma_f32_32x32x16_bf16(f0[dd], qr[hf * 4 + dd], p0, 0, 0, 0); p1 = __builtin_amdgcn_mfma_f32_32x32x16_bf16(f1[dd], qr[hf * 4 + dd], p1, 0, 0, 0); }
    }
}
template <int VB>
__device__ __forceinline__ void pv_tile(f32x16* o, int vb0, bf16x8 pa0, bf16x8 pa1, bf16x8 pa2, bf16x8 pa3) {
#define TRRD(dst, off) asm volatile("ds_read_b64_tr_b16 %0, %1 offset:%2" : "=&v"(dst) : "v"(vb0), "i"(off) : "memory")
#define PV_KS(ks, PA) do { s16x4 l0, l1, l2, l3, h0, h1, h2, h3; constexpr int b_ = VB * SHM + v_rd_off(0, ks, 0); \
        TRRD(l0, b_); TRRD(h0, b_ + 2048); TRRD(l1, b_ + 512); TRRD(h1, b_ + 512 + 2048); TRRD(l2, b_ + 1024); TRRD(h2, b_ + 1024 + 2048); TRRD(l3, b_ + 1536); TRRD(h3, b_ + 1536 + 2048); \
        asm volatile("s_waitcnt lgkmcnt(0)" ::: "memory"); SBAR();   \
        o[0] = __builtin_amdgcn_mfma_f32_32x32x16_bf16(PA, (bf16x8){l0[0], l0[1], l0[2], l0[3], h0[0], h0[1], h0[2], h0[3]}, o[0], 0, 0, 0);   \
        o[1] = __builtin_amdgcn_mfma_f32_32x32x16_bf16(PA, (bf16x8){l1[0], l1[1], l1[2], l1[3], h1[0], h1[1], h1[2], h1[3]}, o[1], 0, 0, 0);   \
        o[2] = __builtin_amdgcn_mfma_f32_32x32x16_bf16(PA, (bf16x8){l2[0], l2[1], l2[2], l2[3], h2[0], h2[1], h2[2], h2[3]}, o[2], 0, 0, 0);   \
        o[3] = __builtin_amdgcn_mfma_f32_32x32x16_bf16(PA, (bf16x8){l3[0], l3[1], l3[2], l3[3], h3[0], h3[1], h3[2], h3[3]}, o[3], 0, 0, 0); } while (0)
    PV_KS(0, pa0); PV_KS(1, pa1); PV_KS(2, pa2); PV_KS(3, pa3);
#undef PV_KS
#undef TRRD
}

__device__ __forceinline__ void prompt_units(char* lds, const bf16* Q, const bf16* Kt, const bf16* Vt, const bf16* SZB, bf16* YB, const float* rel, int it0, int stride, int nit) {
    const int tid = threadIdx.x, wid = __builtin_amdgcn_readfirstlane(tid >> 6), lane = tid & 63, r32 = lane & 31, hi = lane >> 5;
    char* V_lds = lds + OFF_V; char* K_lds = lds + OFF_K; float* tab = (float*)(lds + OFF_TAB);
    float* wsx = (float*)(lds + OFF_WS) + wid * 64; float* li_l = wsx, * al_l = wsx + 32;
    const int sr = tid >> 4, sc = (tid & 15) * 8, vst0 = v_st(sr, sc), vst1 = v_st(32 + sr, sc), kws = KSWZ(sr, sc * 2);
    const int vb0 = (int)(uintptr_t)V_lds + v_rd_base(lane);
    const int qo = 32 * (wid & 1) + r32;
    if (it0 >= nit) return;
    bf16x8 qr[8], st_k0, st_k1, st_v0, st_v1;
#define JLO(qb_) ((4 * (qb_) - 8) > 0 ? (4 * (qb_) - 8) : 0)
#define QLOAD(b_, h_, qb_) do { const bf16* qp_ = Q + (size_t)((b_) * SEQ + (qb_) * 256 + wid * 32 + r32) * DBR + (h_) * HD; \
        _Pragma("unroll") for (int d0 = 0; d0 < 8; ++d0) qr[d0] = *reinterpret_cast<const bf16x8*>(qp_ + d0 * 16 + hi * 8); } while (0)
#define SLOAD(Kp, Vp, k0) do { st_v0 = *reinterpret_cast<const bf16x8*>((Vp) + (size_t)((k0) + sr) * DBR); st_v1 = *reinterpret_cast<const bf16x8*>((Vp) + (size_t)((k0) + 32 + sr) * DBR); \
                               st_k0 = *reinterpret_cast<const bf16x8*>((Kp) + (size_t)((k0) + sr) * DBR); st_k1 = *reinterpret_cast<const bf16x8*>((Kp) + (size_t)((k0) + 32 + sr) * DBR); } while (0)
#define SWRITE(bf) do { *(bf16x8*)(V_lds + (bf) * SHM + vst0) = st_v0; *(bf16x8*)(V_lds + (bf) * SHM + vst1) = st_v1; \
                        *(bf16x8*)(K_lds + (bf) * SHM + kws) = st_k0; *(bf16x8*)(K_lds + (bf) * SHM + kws + 32 * 256) = st_k1; } while (0)
    int it = it0, hprev = -1;
    { const int qb = it >> 7, bh = it & 127, b = bh >> 4, h = bh & 15;
      QLOAD(b, h, qb); SLOAD(Kt + (size_t)(b * SEQ) * DBR + h * HD + sc, Vt + (size_t)(b * SEQ) * DBR + h * HD + sc, JLO(qb) * 64);
      if (tid < NREL) tab[tid] = rel[h * NREL + tid] * (1.0f / SCALE); hprev = h;
      SWRITE(0); __syncthreads(); }
    for (;;) {
        const int qb = it >> 7, bh = it & 127, b = bh >> 4, h = bh & 15;
        const int rowbase = b * SEQ + qb * 256;
        const int j_lo = JLO(qb), NT = 4 * qb + 4 - j_lo;
        const int cw = 4 * qb + (wid >> 1);
        const bf16* Kh = Kt + (size_t)(b * SEQ) * DBR + h * HD + sc; const bf16* Vh = Vt + (size_t)(b * SEQ) * DBR + h * HD + sc;
        float m_reg = -1e30f, l_reg = 0.f; f32x16 o[4] = {};
        const float tab256 = tab[256];
#define STEP(t, BUF) do { \
        if ((t) + 1 < NT) SLOAD(Kh, Vh, (j_lo + (t) + 1) * 64); \
        const int cd = cw - (j_lo + (t)); \
        if (cd >= 0 && cd <= 8) { \
            f32x16 p0, p1; \
            if (cd >= 3) { _Pragma("unroll") for (int r = 0; r < 16; ++r) { p0[r] = tab256; p1[r] = tab256; } } \
            else { const int dq = 64 * cd + qo - 4 * hi + 128; \
                _Pragma("unroll") for (int r = 0; r < 16; ++r) { const int c = (r & 3) + 8 * (r >> 2); int i0 = dq - c, i1 = dq - c - 32; i0 = i0 > 256 ? 256 : i0; i1 = i1 > 256 ? 256 : i1; p0[r] = tab[i0]; p1[r] = tab[i1]; } } \
            SBAR(); qkt<BUF>(p0, p1, K_lds, r32, hi, qr); \
            float mn, al; partialSM(p0, p1, m_reg, mn, al); \
            if (__any(al < 1.f)) { if (hi == 0) al_l[r32] = al; LDS_WAIT(); \
                _Pragma("unroll") for (int d_ = 0; d_ < 4; ++d_) _Pragma("unroll") for (int r = 0; r < 16; ++r) o[d_][r] *= al_l[crow(r, hi)]; } \
            bf16x8 pa0, pa1, pa2, pa3; finishSM(p0, p1, al, l_reg, pa0, pa1, pa2, pa3); SBAR(); \
            pv_tile<BUF>(o, vb0, pa0, pa1, pa2, pa3); \
        } \
        if ((t) + 1 < NT) SWRITE((BUF) ^ 1); \
        __syncthreads(); } while (0)
        for (int t = 0; t < NT; t += 2) { STEP(t, 0); STEP(t + 1, 1); }
#undef STEP
        const int itn = it + stride; const bool more = itn < nit;
        if (more) { const int qbn = itn >> 7, bhn = itn & 127, bn = bhn >> 4, hn = bhn & 15;
            QLOAD(bn, hn, qbn); SLOAD(Kt + (size_t)(bn * SEQ) * DBR + hn * HD + sc, Vt + (size_t)(bn * SEQ) * DBR + hn * HD + sc, JLO(qbn) * 64); }
        if (hi == 0) li_l[r32] = l_reg; LDS_WAIT();
        float rli[16];
#pragma unroll
        for (int r = 0; r < 16; ++r) rli[r] = __builtin_amdgcn_rcpf(li_l[crow(r, hi)]);
        const int odd = r32 & 1;
        unsigned zp[16][2];
#pragma unroll
        for (int r = 0; r < 16; ++r) { const size_t go = (size_t)(rowbase + wid * 32 + crow(r, hi)) * DBR + h * HD + (r32 - odd) + odd * 32;
#pragma unroll
            for (int p = 0; p < 2; ++p) zp[r][p] = *(const unsigned*)(SZB + go + p * 64); }
#pragma unroll
        for (int r = 0; r < 16; ++r) { const size_t go = (size_t)(rowbase + wid * 32 + crow(r, hi)) * DBR + h * HD + (r32 - odd) + odd * 32;
#pragma unroll
            for (int p = 0; p < 2; ++p) { const float va = o[2 * p][r] * rli[r], vb = o[2 * p + 1][r] * rli[r];
                const float keep = odd ? vb : va, recv = __shfl_xor(odd ? va : vb, 1);
                const float lo = odd ? recv : keep, hi_ = odd ? keep : recv;
                *(unsigned*)(YB + go + p * 64) = cvt_pk_bf16(lo * bf_lo(zp[r][p]), hi_ * bf_hi(zp[r][p])); } }
        __syncthreads();
        if (!more) break;
        { const int hn = (itn & 127) & 15; if (hn != hprev) { if (tid < NREL) tab[tid] = rel[hn * NREL + tid] * (1.0f / SCALE); hprev = hn; } }
        SWRITE(0);
        __syncthreads();
        it = itn;
    }
#undef JLO
#undef QLOAD
#undef SLOAD
#undef SWRITE
}

constexpr int S_OFF_P = 0, S_OFF_ML = 8 * 80 * 16 * 4, S_OFF_OW = S_OFF_ML + 8 * 32 * 4 + 0, S_LDS_NEED = S_OFF_OW + 8 * 16 * 128 * 4;
__device__ __forceinline__ void sample_unit(char* lds, const bf16* Q, const bf16* Kt, const bf16* Vt, const bf16* SZB, bf16* YB, const float* ck, const float* cv, const float* rel, int b, int h) {
    const int tid = threadIdx.x, wid = __builtin_amdgcn_readfirstlane(tid >> 6), lane = tid & 63, l15 = lane & 15, kq = lane >> 4;
    float* Pw = (float*)(lds + S_OFF_P) + wid * 80 * 16; float* ML = (float*)(lds + S_OFF_ML); float* OW = (float*)(lds + S_OFF_OW);
    const int rowbase = MP + b * DECT;
    constexpr float L2E = 1.4426950408889634f;
    bf16x8 qf[4];
#pragma unroll
    for (int ks = 0; ks < 4; ++ks) qf[ks] = *reinterpret_cast<const bf16x8*>(Q + (size_t)(rowbase + l15) * DBR + h * HD + ks * 32 + kq * 8);
    const float* relh = rel + h * NREL;
    const int nblk = (wid == 0) ? 5 : 4;
    float sc[5][4];
#pragma unroll
    for (int kb = 0; kb < 5; ++kb) { if (kb < nblk) {
        f32x4 acc = {0.f, 0.f, 0.f, 0.f};
        if (kb < 4) { const float* kp = ck + ((size_t)(b * CACHE + wid * 64 + kb * 16 + l15) * NH + h) * HD + kq * 8;
#pragma unroll
            for (int ks = 0; ks < 4; ++ks) { const f32x4 x0 = *(const f32x4*)(kp + ks * 32), x1 = *(const f32x4*)(kp + ks * 32 + 4);
                v4u w = {cvt_pk_bf16(x0[0], x0[1]), cvt_pk_bf16(x0[2], x0[3]), cvt_pk_bf16(x1[0], x1[1]), cvt_pk_bf16(x1[2], x1[3])};
                acc = __builtin_amdgcn_mfma_f32_16x16x32_bf16(*reinterpret_cast<bf16x8*>(&w), qf[ks], acc, 0, 0, 0); } }
        else { const bf16* kp = Kt + (size_t)(rowbase + l15) * DBR + h * HD + kq * 8;
#pragma unroll
            for (int ks = 0; ks < 4; ++ks) acc = __builtin_amdgcn_mfma_f32_16x16x32_bf16(*reinterpret_cast<const bf16x8*>(kp + ks * 32), qf[ks], acc, 0, 0, 0); }
#pragma unroll
        for (int i = 0; i < 4; ++i) { int d;
            if (kb < 4) d = l15 + CACHE - (wid * 64 + kb * 16 + 4 * kq + i); else d = l15 - (4 * kq + i);
            d = d > 128 ? 128 : d; sc[kb][i] = (acc[i] * SCALE + relh[d + 128]) * L2E; }
    } else {
#pragma unroll
        for (int i = 0; i < 4; ++i) sc[kb][i] = -1e30f; } }
    float mx = -1e30f;
#pragma unroll
    for (int kb = 0; kb < 5; ++kb)
#pragma unroll
        for (int i = 0; i < 4; ++i) mx = fmaxf(mx, sc[kb][i]);
    mx = fmaxf(mx, __shfl_xor(mx, 16)); mx = fmaxf(mx, __shfl_xor(mx, 32));
    float ls = 0.f;
#pragma unroll
    for (int kb = 0; kb < 5; ++kb)
#pragma unroll
        for (int i = 0; i < 4; ++i) { const float p = (kb < nblk) ? __builtin_amdgcn_exp2f(sc[kb][i] - mx) : 0.f; ls += p; if (kb < nblk) Pw[(kb * 16 + 4 * kq + i) * 16 + l15] = p; }
    ls += __shfl_xor(ls, 16); ls += __shfl_xor(ls, 32);
    if (kq == 0) { ML[wid * 32 + l15] = mx; ML[wid * 32 + 16 + l15] = ls; }
    LDS_WAIT();
    f32x2 ov[16];
#pragma unroll
    for (int q = 0; q < 16; ++q) ov[q] = (f32x2){0.f, 0.f};
    const float* vp = cv + ((size_t)(b * CACHE + wid * 64) * NH + h) * HD + 2 * lane;
#pragma unroll 4
    for (int k = 0; k < 64; ++k) { const f32x2 v = *(const f32x2*)(vp + (size_t)k * NH * HD); const f32x4* pr = (const f32x4*)(Pw + k * 16);
#pragma unroll
        for (int q4 = 0; q4 < 4; ++q4) { const f32x4 p = pr[q4];
            ov[4 * q4 + 0] += v * p[0]; ov[4 * q4 + 1] += v * p[1]; ov[4 * q4 + 2] += v * p[2]; ov[4 * q4 + 3] += v * p[3]; } }
    if (wid == 0) {
        for (int k = 0; k < 16; ++k) { const unsigned vw = *(const unsigned*)(Vt + (size_t)(rowbase + k) * DBR + h * HD + 2 * lane); const f32x2 v = {bf_lo(vw), bf_hi(vw)}; const f32x4* pr = (const f32x4*)(Pw + (64 + k) * 16);
#pragma unroll
            for (int q4 = 0; q4 < 4; ++q4) { const f32x4 p = pr[q4];
                ov[4 * q4 + 0] += v * p[0]; ov[4 * q4 + 1] += v * p[1]; ov[4 * q4 + 2] += v * p[2]; ov[4 * q4 + 3] += v * p[3]; } }
    }
#pragma unroll
    for (int q = 0; q < 16; ++q) *(f32x2*)(OW + (wid * 16 + q) * 128 + 2 * lane) = ov[q];
    __syncthreads();
    { const int q = tid >> 5, d = (tid & 31) * 4; float mw[8], Mx = -1e30f;
#pragma unroll
      for (int w = 0; w < 8; ++w) { mw[w] = ML[w * 32 + q]; Mx = fmaxf(Mx, mw[w]); }
      float L = 0.f; f32x4 a = {0.f, 0.f, 0.f, 0.f};
#pragma unroll
      for (int w = 0; w < 8; ++w) { const float e = __builtin_amdgcn_exp2f(mw[w] - Mx); L += e * ML[w * 32 + 16 + q]; a += *(const f32x4*)(OW + (w * 16 + q) * 128 + d) * e; }
      const float rl = 1.0f / L; const size_t go = (size_t)(rowbase + q) * DBR + h * HD + d;
      const v2u z = *(const v2u*)(SZB + go);
      v2u w2; w2.x = cvt_pk_bf16(a[0] * rl * bf_lo(z.x), a[1] * rl * bf_hi(z.x)); w2.y = cvt_pk_bf16(a[2] * rl * bf_lo(z.y), a[3] * rl * bf_hi(z.y));
      *(v2u*)(YB + go) = w2; }
    __syncthreads();
}
}

namespace sgu {
constexpr int PITCH = 272;
constexpr int OFF_VNT = 0, OFF_W = 256 * PITCH, LDS_NEED = OFF_W + 128 * PITCH;
__device__ __forceinline__ void prompt_unit(LAS unsigned char* lds, const bf16* VN, const bf16* UZ, bf16* YA, const bf16* Wm, const float* bs, int b, int n, int g) {
    const int tid = threadIdx.x, wid = __builtin_amdgcn_readfirstlane(tid >> 6), lane = tid & 63, r32 = lane & 31, hi = lane >> 5;
    const int row0 = b * SEQ + n * GCH, c0 = g * GDIM;
#pragma unroll
    for (int it = 0; it < 4; ++it) { const int p = tid + it * 512, r = p >> 4, cpc = p & 15;
        *(LAS v4u*)(lds + OFF_W + r * PITCH + cpc * 16) = *(const v4u*)(Wm + (size_t)g * GCH * GCH + r * GCH + cpc * 8); }
#pragma unroll
    for (int it = 0; it < 4; ++it) { const int cg = wid * 4 + it, jj = lane;
        const v4u a = *(const v4u*)(VN + (size_t)(row0 + 2 * jj) * DBR + c0 + cg * 8), bb = *(const v4u*)(VN + (size_t)(row0 + 2 * jj + 1) * DBR + c0 + cg * 8);
        LAS unsigned char* dst = lds + OFF_VNT + (cg * 8) * PITCH + jj * 4;
        *(LAS unsigned*)(dst + 0 * PITCH) = (a.x & 0xffffu) | (bb.x << 16); *(LAS unsigned*)(dst + 1 * PITCH) = (a.x >> 16) | (bb.x & 0xffff0000u);
        *(LAS unsigned*)(dst + 2 * PITCH) = (a.y & 0xffffu) | (bb.y << 16); *(LAS unsigned*)(dst + 3 * PITCH) = (a.y >> 16) | (bb.y & 0xffff0000u);
        *(LAS unsigned*)(dst + 4 * PITCH) = (a.z & 0xffffu) | (bb.z << 16); *(LAS unsigned*)(dst + 5 * PITCH) = (a.z >> 16) | (bb.z & 0xffff0000u);
        *(LAS unsigned*)(dst + 6 * PITCH) = (a.w & 0xffffu) | (bb.w << 16); *(LAS unsigned*)(dst + 7 * PITCH) = (a.w >> 16) | (bb.w & 0xffff0000u); }
    __syncthreads();
    f32x16 acc[4] = {};
#pragma unroll
    for (int ks = 0; ks < 8; ++ks) {
        const bf16x8 a = *(const LAS bf16x8*)(lds + OFF_VNT + (wid * 32 + r32) * PITCH + (ks * 16 + hi * 8) * 2);
#pragma unroll
        for (int ib = 0; ib < 4; ++ib) { if (ib < 2 && ks >= 4) continue;
            const bf16x8 w = *(const LAS bf16x8*)(lds + OFF_W + (ib * 32 + r32) * PITCH + (ks * 16 + hi * 8) * 2);
            acc[ib] = __builtin_amdgcn_mfma_f32_32x32x16_bf16(a, w, acc[ib], 0, 0, 0); } }
    v2u uu[4][4]; float bsv[4];
#pragma unroll
    for (int ib = 0; ib < 4; ++ib) { const int i = ib * 32 + r32; bsv[ib] = bs[g * GCH + i]; const size_t ro = (size_t)(row0 + i) * DBR + c0 + wid * 32 + 4 * hi;
#pragma unroll
        for (int rq = 0; rq < 4; ++rq) uu[ib][rq] = *(const v2u*)(UZ + ro + 8 * rq); }
#pragma unroll
    for (int ib = 0; ib < 4; ++ib) { const int i = ib * 32 + r32; const float bsi = bsv[ib]; const size_t ro = (size_t)(row0 + i) * DBR + c0 + wid * 32 + 4 * hi;
#pragma unroll
        for (int rq = 0; rq < 4; ++rq) { const size_t go = ro + 8 * rq; const v2u u2 = uu[ib][rq];
            const float y0 = bf_lo(u2.x) * (acc[ib][4 * rq + 0] + bsi), y1 = bf_hi(u2.x) * (acc[ib][4 * rq + 1] + bsi);
            const float y2 = bf_lo(u2.y) * (acc[ib][4 * rq + 2] + bsi), y3 = bf_hi(u2.y) * (acc[ib][4 * rq + 3] + bsi);
            v2u w2; w2.x = cvt_pk_bf16(y0, y1); w2.y = cvt_pk_bf16(y2, y3); *(v2u*)(YA + go) = w2; } }
    __syncthreads();
}
__device__ __forceinline__ void sample_unit(const bf16* VN, const bf16* UZ, bf16* YA, const float* w_s, const float* bs, int b, int iq) {
    const int tid = threadIdx.x, c = tid * 4, g = c >> 8; const int row0 = MP + b * DECT;
    f32x4 v[16];
#pragma unroll
    for (int j = 0; j < 16; ++j) { const v2u x = *(const v2u*)(VN + (size_t)(row0 + j) * DBR + c); v[j] = (f32x4){bf_lo(x.x), bf_hi(x.x), bf_lo(x.y), bf_hi(x.y)}; }
    v2u uq[4];
#pragma unroll
    for (int ii = 0; ii < 4; ++ii) { const size_t go = (size_t)(row0 + iq * 4 + ii) * DBR + c; uq[ii] = *(const v2u*)(UZ + go); }
#pragma unroll
    for (int ii = 0; ii < 4; ++ii) { const int i = iq * 4 + ii; const float* wr = w_s + ((size_t)g * GCH + i) * GCH; const float bsi = bs[g * GCH + i]; f32x4 a = {bsi, bsi, bsi, bsi};
        const size_t go = (size_t)(row0 + i) * DBR + c; const v2u u2 = uq[ii];
#pragma unroll
        for (int j = 0; j < 16; ++j) a += v[j] * wr[j];
        v2u w2; w2.x = cvt_pk_bf16(bf_lo(u2.x) * a[0], bf_hi(u2.x) * a[1]); w2.y = cvt_pk_bf16(bf_lo(u2.y) * a[2], bf_hi(u2.y) * a[3]);
        *(v2u*)(YA + go) = w2; }
}
}

constexpr int NWAVES = 8;
constexpr int N_PHASES = 8;
constexpr int N_LAUNCHES = MK_N_LAUNCHES;
constexpr int RING_OFF = 0, RING_BYTES = 131072;
constexpr int LDSCTL_OFF = 143360, MISC_OFF = LDSCTL_OFF + 320;
constexpr int LDS_BYTES = 147456;
static_assert(att::LDS_NEED <= LDSCTL_OFF && att::S_LDS_NEED <= LDSCTL_OFF && sgu::LDS_NEED <= LDSCTL_OFF && 8 * 64 * 65 * 4 <= LDSCTL_OFF && MISC_OFF + 128 <= LDS_BYTES, "LDS map");

#define XB_TMO      128
#define XB_XCNT(j)  (256  + 64 * (j))
#define XB_XSUB(j)  (1280 + 64 * (j))
#define XB_XGEN(j)  (2304 + 64 * (j))
#define XB_TOP      3328
#define XB_TOPGEN   3392
#define XCD_BAR_WORDS 3456
#define XB_SPIN_CAP (1u << 18)
__device__ __forceinline__ unsigned xb_ld(unsigned* p)              { return __hip_atomic_load(p, __ATOMIC_RELAXED, __HIP_MEMORY_SCOPE_AGENT); }
__device__ __forceinline__ unsigned xb_add(unsigned* p, unsigned v) { return __hip_atomic_fetch_add(p, v, __ATOMIC_RELAXED, __HIP_MEMORY_SCOPE_AGENT); }
__device__ __forceinline__ unsigned xb_xcc_id() { return (unsigned)__builtin_amdgcn_s_getreg((3 << 11) | 20) & 0xFu; }
#define XB_SPIN(cond, bar) do { unsigned _sp = 0; while (cond) { __builtin_amdgcn_s_sleep(1); \
    if ((++_sp & 255u) == 0u) { if (xb_ld(&(bar)[XB_TMO])) break; if (_sp > XB_SPIN_CAP) { atomicAdd(&(bar)[XB_TMO], 1u); break; } } } } while (0)
struct XcdBarrier { unsigned* bar; unsigned x; volatile LAS unsigned* st; };
__device__ __forceinline__ XcdBarrier xcd_barrier_post(unsigned* bar, volatile LAS unsigned* st) {
    XcdBarrier b; b.bar = bar; b.x = xb_xcc_id(); b.st = st;
    if (threadIdx.x == 0) (void)xb_add(&bar[XB_XCNT(b.x)], 1u);
    return b;
}
__device__ __forceinline__ void xcd_barrier_complete(unsigned* bar, unsigned x, unsigned& nloc, unsigned& nx) {
    const unsigned G = gridDim.x * gridDim.y * gridDim.z;
    unsigned sum, cnt, mine, sp = 0u;
    for (;;) {
        sum = 0u; cnt = 0u; mine = 0u;
#pragma unroll
        for (unsigned j = 0; j < 16; ++j) { const unsigned c = xb_ld(&bar[XB_XCNT(j)]); sum += c; cnt += (c > 0u) ? 1u : 0u; mine = (j == x) ? c : mine; }
        if (sum == G) break;
        __builtin_amdgcn_s_sleep(1);
        if ((++sp & 255u) == 0u) { if (xb_ld(&bar[XB_TMO])) break; if (sp > XB_SPIN_CAP) { atomicAdd(&bar[XB_TMO], 1u); break; } }
    }
    nloc = mine > 0u ? mine : 1u; nx = cnt > 0u ? cnt : 1u;
}
__device__ __forceinline__ void xcd_barrier(const XcdBarrier& b) {
    asm volatile("s_waitcnt vmcnt(0)" ::: "memory");
    __syncthreads();
    if (threadIdx.x == 0) {
        unsigned* bar = b.bar;
        __builtin_amdgcn_s_waitcnt(0);
        unsigned nloc = b.st[0], nx = b.st[1];
        if (nloc == 0u) { xcd_barrier_complete(bar, b.x, nloc, nx); b.st[0] = nloc; b.st[1] = nx; }
        const unsigned old = xb_add(&bar[XB_XSUB(b.x)], 1u);
        const unsigned gen = old / nloc;
        if (old + 1u == (gen + 1u) * nloc) {
            __builtin_amdgcn_fence(__ATOMIC_RELEASE, "agent");
            asm volatile("s_waitcnt vmcnt(0)" ::: "memory");
            const unsigned og = xb_add(&bar[XB_TOP], 1u);
            const unsigned tg = og / nx;
            if (og + 1u == (tg + 1u) * nx) xb_add(&bar[XB_TOPGEN], 1u);
            else XB_SPIN(xb_ld(&bar[XB_TOPGEN]) == tg, bar);
            __builtin_amdgcn_fence(__ATOMIC_ACQUIRE, "agent");
            xb_add(&bar[XB_XGEN(b.x)], 1u);
            asm volatile("s_waitcnt vmcnt(0)" ::: "memory");
        } else {
            XB_SPIN(xb_ld(&bar[XB_XGEN(b.x)]) == gen, bar);
            __builtin_amdgcn_fence(__ATOMIC_ACQUIRE, "agent");
            asm volatile("s_waitcnt vmcnt(0)" ::: "memory");
        }
    }
    __syncthreads();
}

__device__ __forceinline__ int win_src_col(int np) {
    if (np < 2 * DBR) { const int c4 = np >> 3, e = np & 3, hf = (np >> 2) & 1; return (hf ? 2 * DBR : 0) + 4 * c4 + e; }
    if (np < 3 * DBR) return np - 2 * DBR + DBR;
    if (np < 7 * DBR) return np;
    { const int m = np - 7 * DBR, c4 = m >> 3, e = m & 3, hf = (m >> 2) & 1; return 7 * DBR + (hf ? DM : 0) + 4 * c4 + e; }
}
template <bool PERMC>
__device__ __forceinline__ void transpose_item(const float* W, int K, int N, bf16* WT, LAS float* scr, int item, int lane) {
    const int nblk = N / 64, kb = item / nblk, nb = item % nblk, k0 = 64 * kb, n0 = 64 * nb;
    const float* src = W + (size_t)k0 * N + (PERMC ? win_src_col(n0 + lane) : n0 + lane);
    float v[64];
#pragma unroll
    for (int i = 0; i < 64; ++i) v[i] = src[(size_t)i * N];
#pragma unroll
    for (int i = 0; i < 64; ++i) scr[i * 65 + lane] = v[i];
    LDS_WAIT(); asm volatile("" ::: "memory");
    const int c = lane & 7;
#pragma unroll
    for (int j = 0; j < 8; ++j) { const int n = (lane >> 3) + 8 * j; const LAS float* s = scr + (8 * c) * 65 + n;
        v4u o; o.x = cvt_pk_bf16(s[0 * 65], s[1 * 65]); o.y = cvt_pk_bf16(s[2 * 65], s[3 * 65]); o.z = cvt_pk_bf16(s[4 * 65], s[5 * 65]); o.w = cvt_pk_bf16(s[6 * 65], s[7 * 65]);
        *(v4u*)(WT + (size_t)(n0 + n) * K + k0 + 8 * c) = o; }
    LDS_WAIT(); asm volatile("" ::: "memory");
}
#define RMS_LOAD(V, xrow_) do { const f32x4* xr_ = (const f32x4*)(xrow_) + lane; _Pragma("unroll") for (int j = 0; j < 16; ++j) V[j] = xr_[64 * j]; } while (0)
#define RMS_PROC(V, orow_) do { float s_ = 0.f; _Pragma("unroll") for (int j = 0; j < 16; ++j) s_ += (V[j].x * V[j].x + V[j].y * V[j].y) + (V[j].z * V[j].z + V[j].w * V[j].w); \
        const float r_ = 1.0f / sqrtf(wave_sum(s_) * (1.f / DM) + EPS); v2u* o8_ = (v2u*)(orow_) + lane; \
        _Pragma("unroll") for (int j = 0; j < 16; ++j) { const f32x4 gg = ((const LAS f32x4*)gl)[lane + 64 * j]; v2u w; w.x = cvt_pk_bf16(V[j].x * r_ * gg.x, V[j].y * r_ * gg.y); w.y = cvt_pk_bf16(V[j].z * r_ * gg.z, V[j].w * r_ * gg.w); o8_[64 * j] = w; } } while (0)

struct Args { const float* in[19]; float* out; unsigned char* ws; int ph_lo, ph_hi, li, pad; };

__global__ void __launch_bounds__(NWAVES * 64, 2) fwd_kernel(Args args) {
    extern __shared__ __attribute__((aligned(16))) unsigned char lds_raw[];
    LAS unsigned char* lds = (LAS unsigned char*)lds_raw;
    const int tid = threadIdx.x, lane = tid & 63, wave = __builtin_amdgcn_readfirstlane(tid >> 6);
    const int G = gridDim.x, bx = blockIdx.x;
    const int vcu = (G % 8 == 0) ? (bx % 8) * (G / 8) + bx / 8 : bx;
    unsigned char* ws = args.ws;
    gu32* ctl = (gu32*)(ws + WS_CTL);
    const float* x_prompt = args.in[0]; const float* x_sample = args.in[1]; const float* cache_k = args.in[2]; const float* cache_v = args.in[3];
    const float* p_prompt = args.in[4]; const float* p_sample = args.in[5]; const float* pre_g = args.in[6]; const float* post_g = args.in[7];
    const float* w_in = args.in[8]; const float* ln_g = args.in[9]; const float* ln_b = args.in[10]; const float* w_s = args.in[11]; const float* b_s = args.in[12];
    const float* rel_bias = args.in[13]; const float* w_up_a = args.in[14]; const float* w_up_b = args.in[15]; const float* w_out = args.in[16];
    const float* w_pg = args.in[17]; const float* w_pp = args.in[18];
    float* out = args.out;
    bf16* WIN_T = (bf16*)(ws + WS_WIN); bf16* WUA_T = (bf16*)(ws + WS_WUA); bf16* WUB_T = (bf16*)(ws + WS_WUB); bf16* WOUT_T = (bf16*)(ws + WS_WOUT);
    bf16* WPG_T = (bf16*)(ws + WS_WPG); bf16* WPP_T = (bf16*)(ws + WS_WPP); bf16* WSM = (bf16*)(ws + WS_WS); bf16* PB = (bf16*)(ws + WS_PB);
    bf16* HB = (bf16*)(ws + WS_H); bf16* YA = (bf16*)(ws + WS_H); bf16* YB = (bf16*)(ws + WS_H + SEG2K);
    bf16* SEG = (bf16*)(ws + WS_SEG);
    bf16* GU = SEG; bf16* GV = SEG + (size_t)M * DBR; bf16* SZA = SEG + (size_t)2 * M * DBR; bf16* QB = SEG + (size_t)3 * M * DBR; bf16* KB = SEG + (size_t)4 * M * DBR;
    bf16* VB = SEG + (size_t)5 * M * DBR; bf16* SZB = SEG + (size_t)6 * M * DBR; bf16* SGA = SEG + (size_t)7 * M * DBR; bf16* SGB = SGA + (size_t)M * DM;
    bf16* SLAB = (bf16*)(ws + WS_SLAB); bf16* PBUF = (bf16*)(ws + WS_P); bf16* MBUF = (bf16*)(ws + WS_MBUF); bf16* TB = (bf16*)(ws + WS_T); bf16* X1B = (bf16*)(ws + WS_X1B);

    for (int u = tid; u < (LDS_BYTES - LDSCTL_OFF) / 4; u += NWAVES * 64) ((LAS unsigned*)(lds + LDSCTL_OFF))[u] = 0u;
    __syncthreads();
    volatile LAS unsigned* MISC = (volatile LAS unsigned*)(lds + MISC_OFF);
    XcdBarrier bar; bar.bar = (unsigned*)(ctl + CW_BAR); bar.x = 0; bar.st = nullptr;
    if (N_LAUNCHES == 1) bar = xcd_barrier_post((unsigned*)(ctl + CW_BAR), MISC + 8);
#define GRID_BAR() do { if (N_LAUNCHES == 1) xcd_barrier(bar); } while (0)
    const int lo = args.ph_lo, hi = args.ph_hi;
#define IN(k) (lo <= (k) && (k) < hi)
#define BOTH(k) (IN(k) && IN((k) + 1))
    const int gw = vcu * NWAVES + wave, NGW = G * NWAVES;

    if (IN(0)) {
        LAS float* scr = (LAS float*)(lds + wave * (64 * 65 * 4));
        constexpr int I_IN = (DM / 64) * (NIN / 64), I_UP = (DBR / 64) * (DM / 64), I_SQ = (DM / 64) * (DM / 64), I_PP = (PLE / 64) * (DM / 64);
        constexpr int NITEMS = I_IN + 2 * I_UP + 2 * I_SQ + I_PP;
        for (int it = gw; it < NITEMS; it += NGW) {
            int r = it;
            if (r < I_IN) { transpose_item<true>(w_in, DM, NIN, WIN_T, scr, r, lane); continue; } r -= I_IN;
            if (r < I_UP) { transpose_item<false>(w_up_a, DBR, DM, WUA_T, scr, r, lane); continue; } r -= I_UP;
            if (r < I_UP) { transpose_item<false>(w_up_b, DBR, DM, WUB_T, scr, r, lane); continue; } r -= I_UP;
            if (r < I_SQ) { transpose_item<false>(w_out, DM, DM, WOUT_T, scr, r, lane); continue; } r -= I_SQ;
            if (r < I_SQ) { transpose_item<false>(w_pg, DM, DM, WPG_T, scr, r, lane); continue; } r -= I_SQ;
            transpose_item<false>(w_pp, PLE, DM, WPP_T, scr, r, lane);
        }
        { __syncthreads();
          LAS float* gl = (LAS float*)lds;
          for (int i = tid; i < DM / 4; i += NWAVES * 64) ((LAS f32x4*)gl)[i] = ((const f32x4*)pre_g)[i];
          __syncthreads();
#define XROW(m_) ((m_) < MP ? x_prompt + (size_t)(m_) * DM : x_sample + (size_t)((m_) - MP) * DM)
          const int m0 = (NGW == 2048 ? ((gw + 1024) & 2047) : gw);
          f32x4 va[16], vb[16];
          if (m0 < M) RMS_LOAD(va, XROW(m0));
          for (int m = m0; m < M; m += 2 * NGW) {
              if (m + NGW < M) RMS_LOAD(vb, XROW(m + NGW));
              asm volatile("" ::: "memory");
              RMS_PROC(va, HB + (size_t)m * DM);
              if (m + NGW < M) { if (m + 2 * NGW < M) RMS_LOAD(va, XROW(m + 2 * NGW));
                  asm volatile("" ::: "memory");
                  RMS_PROC(vb, HB + (size_t)(m + NGW) * DM); } }
#undef XROW
        }
        { const int gt = vcu * 512 + tid, NT_ = G * 512;
          for (int i = gt; i < M * PLE / 4; i += NT_) { const int m = (i * 4) / PLE; const f32x4 v = (m < MP) ? ((const f32x4*)p_prompt)[i] : ((const f32x4*)p_sample)[i - MP * PLE / 4];
              v2u w; w.x = cvt_pk_bf16(v.x, v.y); w.y = cvt_pk_bf16(v.z, v.w); ((v2u*)PB)[i] = w; }
          for (int i = gt; i < NGRP * GCH * GCH; i += NT_) { const int ii = (i >> 7) & 127, jj = i & 127; const float v = ((jj >> 6) <= (ii >> 6)) ? w_s[i] : 0.f; WSM[i] = (bf16)(cvt_pk_bf16(v, 0.f) & 0xffffu); } }
        if (BOTH(0)) GRID_BAR();
    }
    if (IN(1)) {
        pg8::Order S; S.init(HB, WIN_T, HB, WIN_T, DM, DM, M, NIN, DM, 1, G, bx, 0, 0, 0);
        pg8::EpiIn E{SEG, out};
        pg8::gemm_phase<pg8::EpiIn, false>(lds + RING_OFF, S, E);
        if (BOTH(1)) GRID_BAR();
    }
    if (IN(2)) {
        f32x4 lg[4][2], lb[4][2];
#pragma unroll
        for (int j = 0; j < 4; ++j) { const int c = (lane + 64 * j) * 8; lg[j][0] = *(const f32x4*)(ln_g + c); lg[j][1] = *(const f32x4*)(ln_g + c + 4); lb[j][0] = *(const f32x4*)(ln_b + c); lb[j][1] = *(const f32x4*)(ln_b + c + 4); }
        for (int m = gw; m < M; m += NGW) {
            v4u* rp = (v4u*)(GV + (size_t)m * DBR) + lane;
            float v[32]; float s = 0.f;
#pragma unroll
            for (int j = 0; j < 4; ++j) { const v4u w = rp[64 * j]; v[8 * j + 0] = bf_lo(w.x); v[8 * j + 1] = bf_hi(w.x); v[8 * j + 2] = bf_lo(w.y); v[8 * j + 3] = bf_hi(w.y);
                v[8 * j + 4] = bf_lo(w.z); v[8 * j + 5] = bf_hi(w.z); v[8 * j + 6] = bf_lo(w.w); v[8 * j + 7] = bf_hi(w.w); }
#pragma unroll
            for (int j = 0; j < 32; ++j) s += v[j];
            const float mean = wave_sum(s) * (1.f / DBR); float s2 = 0.f;
#pragma unroll
            for (int j = 0; j < 32; ++j) { v[j] -= mean; s2 += v[j] * v[j]; }
            const float rstd = 1.0f / sqrtf(wave_sum(s2) * (1.f / DBR) + EPS);
            float* fo = nullptr;
            if (m >= MP) fo = out + OFF_GS + (size_t)(m - MP) * DBR; else if ((m & (SEQ - 1)) >= SEQ - GCH) fo = out + OFF_GP + (size_t)((m >> 11) * GCH + (m & (SEQ - 1)) - (SEQ - GCH)) * DBR;
#pragma unroll
            for (int j = 0; j < 4; ++j) { const int c = (lane + 64 * j) * 8; const f32x4 g0 = lg[j][0], g1 = lg[j][1], b0 = lb[j][0], b1 = lb[j][1];
                f32x4 y0, y1; y0[0] = v[8 * j + 0] * rstd * g0[0] + b0[0]; y0[1] = v[8 * j + 1] * rstd * g0[1] + b0[1]; y0[2] = v[8 * j + 2] * rstd * g0[2] + b0[2]; y0[3] = v[8 * j + 3] * rstd * g0[3] + b0[3];
                y1[0] = v[8 * j + 4] * rstd * g1[0] + b1[0]; y1[1] = v[8 * j + 5] * rstd * g1[1] + b1[1]; y1[2] = v[8 * j + 6] * rstd * g1[2] + b1[2]; y1[3] = v[8 * j + 7] * rstd * g1[3] + b1[3];
                if (fo) { *(f32x4*)(fo + c) = y0; *(f32x4*)(fo + c + 4) = y1; }
                v4u w; w.x = cvt_pk_bf16(y0[0], y0[1]); w.y = cvt_pk_bf16(y0[2], y0[3]); w.z = cvt_pk_bf16(y1[0], y1[1]); w.w = cvt_pk_bf16(y1[2], y1[3]); rp[64 * j] = w; }
        }
        __syncthreads();
        { pg8::Order S; S.init(PB, WPP_T, PB, WPP_T, PLE, PLE, M, DM, PLE, 1, G, bx, 0, 0, 0);
          pg8::EpiStore E{PBUF, DM, nullptr, 0};
          pg8::gemm_phase<pg8::EpiStore>(lds + RING_OFF, S, E); }
        if (BOTH(2)) GRID_BAR();
    }
    if (IN(3)) {
        att::prompt_units((char*)lds_raw, QB, KB, VB, SZB, YB, rel_bias, bx, G, NB * NH * 8);
        for (int it = bx; it < DECB * NH; it += G) att::sample_unit((char*)lds_raw, QB, KB, VB, SZB, YB, cache_k, cache_v, rel_bias, it >> 4, it & 15);
        for (int it = bx; it < NB * 16 * NGRP; it += G) sgu::prompt_unit(lds, GV, GU, YA, WSM, b_s, it >> 7, (it >> 3) & 15, it & 7);
        for (int it = bx; it < DECB * 4; it += (G == 256 ? 128 : G)) { if (G == 256 && bx >= 128) break; sgu::sample_unit(GV, GU, YA, w_s, b_s, it >> 2, it & 3); }
        if (BOTH(3)) GRID_BAR();
    }
    if (IN(4)) {
        { pg8::Order S; S.init(YA, WUA_T, YB, WUB_T, DBR, DBR, MP, DM, DBR, 2, G, bx, 0, 0, 0);
          pg8::EpiMerge E{SGA, SGB, MBUF};
          pg8::gemm_phase<pg8::EpiMerge>(lds + RING_OFF, S, E); }
        { pg8::Order S; S.init(YA, WUA_T, YB, WUB_T, DBR, DBR, 0, DM, DBR, 2, G, bx, MS, 8, MP / 256);
          pg8::EpiMergeSub E{SGA, SGB, SLAB, MP / 256};
          pg8::gemm_phase<pg8::EpiMergeSub>(lds + RING_OFF, S, E); }
        GRID_BAR();
        for (int i = vcu * 512 + tid; i < MS * DM / 8; i += G * 512) { f32x4 a0 = {0.f, 0.f, 0.f, 0.f}, a1 = a0;
#pragma unroll
            for (int k = 0; k < 8; ++k) { const v4u p = *(const v4u*)(SLAB + (size_t)k * (MS * DM) + (size_t)i * 8); a0 += (f32x4){bf_lo(p.x), bf_hi(p.x), bf_lo(p.y), bf_hi(p.y)}; a1 += (f32x4){bf_lo(p.z), bf_hi(p.z), bf_lo(p.w), bf_hi(p.w)}; }
            v4u w; w.x = cvt_pk_bf16(a0[0], a0[1]); w.y = cvt_pk_bf16(a0[2], a0[3]); w.z = cvt_pk_bf16(a1[0], a1[1]); w.w = cvt_pk_bf16(a1[2], a1[3]);
            *(v4u*)(MBUF + (size_t)MP * DM + (size_t)i * 8) = w; }
        if (BOTH(4)) GRID_BAR();
    }
    if (IN(5)) {
        pg8::Order S; S.init(MBUF, WOUT_T, MBUF, WOUT_T, DM, DM, MP, DM, DM, 1, G, bx, MS, 8, MP / 256); S.sub_first = bx & 1;
        pg8::EpiStore E{TB, DM, SLAB, MP / 256};
        pg8::gemm_phase<pg8::EpiStore>(lds + RING_OFF, S, E);
        if (BOTH(5)) GRID_BAR();
    }
    if (IN(6)) {
        f32x4 pg[8][2];
#pragma unroll
        for (int j = 0; j < 8; ++j) { const int c = (lane + 64 * j) * 8; pg[j][0] = *(const f32x4*)(post_g + c); pg[j][1] = *(const f32x4*)(post_g + c + 4); }
        const bool deal = (NGW == 2048); const int own_s = deal && gw < MS;
        const int r0 = deal ? (gw < MS ? gw * 5 : MS * 5 + (gw - MS) * 9) : gw, nrow = deal ? (gw < MS ? 6 : 9) : (M - gw + NGW - 1) / NGW;
        for (int j = 0; j < nrow; ++j) {
            const int m = deal ? ((own_s && j == 0) ? MP + gw : r0 + j - own_s) : gw + j * NGW;
            const float* xrow = m < MP ? x_prompt + (size_t)m * DM : x_sample + (size_t)(m - MP) * DM;
            f32x4 t0[8], t1[8], x0[8], x1[8]; float s = 0.f;
#pragma unroll
            for (int j = 0; j < 8; ++j) { const int c = (lane + 64 * j) * 8; x0[j] = *(const f32x4*)(xrow + c); x1[j] = *(const f32x4*)(xrow + c + 4); }
            if (m >= MP) {
#pragma unroll
                for (int j = 0; j < 8; ++j) { const int c = (lane + 64 * j) * 8; f32x4 a0 = {0.f, 0.f, 0.f, 0.f}, a1 = a0;
#pragma unroll
                    for (int k = 0; k < 8; ++k) { const v4u p = *(const v4u*)(SLAB + (size_t)k * (MS * DM) + (size_t)(m - MP) * DM + c); a0 += (f32x4){bf_lo(p.x), bf_hi(p.x), bf_lo(p.y), bf_hi(p.y)}; a1 += (f32x4){bf_lo(p.z), bf_hi(p.z), bf_lo(p.w), bf_hi(p.w)}; }
                    t0[j] = a0; t1[j] = a1; }
            } else {
                const v4u* tp = (const v4u*)(TB + (size_t)m * DM) + lane; v4u tw[8];
#pragma unroll
                for (int j = 0; j < 8; ++j) tw[j] = tp[64 * j];
#pragma unroll
                for (int j = 0; j < 8; ++j) { t0[j] = (f32x4){bf_lo(tw[j].x), bf_hi(tw[j].x), bf_lo(tw[j].y), bf_hi(tw[j].y)}; t1[j] = (f32x4){bf_lo(tw[j].z), bf_hi(tw[j].z), bf_lo(tw[j].w), bf_hi(tw[j].w)}; }
            }
#pragma unroll
            for (int j = 0; j < 8; ++j) { const f32x4 a0 = t0[j], a1 = t1[j]; s += (a0[0] * a0[0] + a0[1] * a0[1]) + (a0[2] * a0[2] + a0[3] * a0[3]) + (a1[0] * a1[0] + a1[1] * a1[1]) + (a1[2] * a1[2] + a1[3] * a1[3]); }
            const float r = 1.0f / sqrtf(wave_sum(s) * (1.f / DM) + EPS);
            float* yo = out + OFF_Y + (size_t)m * DM; v4u* xb = (v4u*)(X1B + (size_t)m * DM) + lane;
#pragma unroll
            for (int j = 0; j < 8; ++j) { const int c = (lane + 64 * j) * 8; const f32x4 y0 = x0[j] + t0[j] * r * pg[j][0], y1 = x1[j] + t1[j] * r * pg[j][1];
                if (m >= MP) { *(f32x4*)(yo + c) = y0; *(f32x4*)(yo + c + 4) = y1; }
                v4u w; w.x = cvt_pk_bf16(y0[0], y0[1]); w.y = cvt_pk_bf16(y0[2], y0[3]); w.z = cvt_pk_bf16(y1[0], y1[1]); w.w = cvt_pk_bf16(y1[2], y1[3]); xb[64 * j] = w; }
        }
        if (BOTH(6)) GRID_BAR();
    }
    if (IN(7)) {
        pg8::Order S; S.init(X1B, WPG_T, X1B, WPG_T, DM, DM, MP, DM, DM, 1, G, bx, MS, 8, MP / 256); S.sub_first = bx & 1;
        pg8::EpiFinal E{out + OFF_Y, PBUF, SLAB, MP / 256, X1B};
        pg8::gemm_phase<pg8::EpiFinal>(lds + RING_OFF, S, E);
        GRID_BAR();
        for (int i = vcu * 512 + tid; i < MS * DM / 4; i += G * 512) { f32x4 a = {0.f, 0.f, 0.f, 0.f};
#pragma unroll
            for (int k = 0; k < 8; ++k) { const v2u p = *(const v2u*)(SLAB + (size_t)k * (MS * DM) + (size_t)i * 4); a += (f32x4){bf_lo(p.x), bf_hi(p.x), bf_lo(p.y), bf_hi(p.y)}; }
            float* yp = out + OFF_Y + (size_t)MP * DM + (size_t)i * 4; const f32x4 x1 = *(const f32x4*)yp; const v2u p = *(const v2u*)(PBUF + (size_t)MP * DM + (size_t)i * 4);
            f32x4 y; y[0] = x1[0] + sigmoid_f(a[0]) * bf_lo(p.x); y[1] = x1[1] + sigmoid_f(a[1]) * bf_hi(p.x); y[2] = x1[2] + sigmoid_f(a[2]) * bf_lo(p.y); y[3] = x1[3] + sigmoid_f(a[3]) * bf_hi(p.y);
            *(f32x4*)yp = y; }
    }
#undef IN
#undef BOTH
#undef GRID_BAR
}

extern "C" void kernel_launch(void* const* d_in, const int* in_sizes, int n_in, void* d_out, int out_size, void* d_ws, size_t ws_size, hipStream_t stream) {
    static int grid = 0;
    if (grid == 0) {
        if (n_in != 19 || (size_t)out_size != OUT_TOTAL || ws_size < WS_END) { fprintf(stderr, "kernel_launch: unexpected shapes: n_in %d out %d ws %zu (need %zu)\n", n_in, out_size, ws_size, (size_t)WS_END); grid = -1; return; }
        int dev = 0, cus = 0, per_cu = 0;
        if (hipGetDevice(&dev) != hipSuccess || hipDeviceGetAttribute(&cus, hipDeviceAttributeMultiprocessorCount, dev) != hipSuccess) { grid = -1; return; }
        if (hipFuncSetAttribute((const void*)fwd_kernel, hipFuncAttributeMaxDynamicSharedMemorySize, LDS_BYTES) != hipSuccess) { fprintf(stderr, "kernel_launch: hipFuncSetAttribute failed\n"); grid = -1; return; }
        if (hipOccupancyMaxActiveBlocksPerMultiprocessor(&per_cu, (const void*)fwd_kernel, NWAVES * 64, LDS_BYTES) != hipSuccess || per_cu < 1)
            fprintf(stderr, "kernel_launch: note: occupancy query reports %d workgroups per CU\n", per_cu);
        (void)hipGetLastError();
        grid = cus;
    }
    if (grid < 0) return;
    if (hipMemsetAsync((char*)d_ws + WS_CTL, 0, CTL_ZERO_BYTES, stream) != hipSuccess) return;
    Args a{};
    for (int i = 0; i < 19; ++i) a.in[i] = (const float*)d_in[i];
    a.out = (float*)d_out; a.ws = (unsigned char*)d_ws;
    for (int li = 0; li < N_LAUNCHES; ++li) {
        a.ph_lo = (N_LAUNCHES == 1) ? 0 : li; a.ph_hi = (N_LAUNCHES == 1) ? N_PHASES : li + 1; a.li = li;
        hipLaunchKernelGGL(fwd_kernel, dim3(grid), dim3(NWAVES * 64), LDS_BYTES, stream, a);
        const hipError_t le = hipPeekAtLastError();
        if (le != hipSuccess) { fprintf(stderr, "kernel_launch: launch %d failed: %s\n", li, hipGetErrorName(le)); break; }
    }
}
```

```cpp
#include <hip/hip_runtime.h>
#include <cstdio>
#include <cstdint>

#ifndef MK_N_LAUNCHES
#define MK_N_LAUNCHES 1
#endif

constexpr int DM = 4096, DBR = 2048, NB = 8, SEQ = 2048, DECB = 32, DECT = 16;
constexpr int MP = NB * SEQ, MS = DECB * DECT, M = MP + MS;
constexpr int NIN = 7 * DBR + 2 * DM;
constexpr int NH = 16, HD = 128, PLE = 256, NGRP = 8, GCH = 128, GDIM = 256, CACHE = 512, NREL = 257;
constexpr float EPS = 1e-6f;
constexpr size_t OFF_Y = 0, OFF_KP = (size_t)M * DM, OFF_VP = OFF_KP + (size_t)NB * 512 * DBR, OFF_KS = OFF_VP + (size_t)NB * 512 * DBR,
                 OFF_VS = OFF_KS + (size_t)MS * DBR, OFF_GP = OFF_VS + (size_t)MS * DBR, OFF_GS = OFF_GP + (size_t)NB * GCH * DBR, OUT_TOTAL = OFF_GS + (size_t)MS * DBR;
constexpr size_t MiB = 1u << 20;
constexpr size_t WS_CTL = 0, CTL_ZERO_BYTES = 1 * MiB;
constexpr size_t WS_WIN = 1 * MiB, WS_WUA = 177 * MiB, WS_WUB = 193 * MiB, WS_WOUT = 209 * MiB, WS_WPG = 241 * MiB, WS_WPP = 273 * MiB, WS_WS = 275 * MiB, WS_PB = 276 * MiB;
constexpr size_t WS_H = 285 * MiB;
constexpr size_t WS_SEG = 417 * MiB;
constexpr size_t SEG2K = (size_t)M * DBR * 2;
constexpr size_t WS_P = 1143 * MiB, WS_SLAB = 1275 * MiB, WS_END = 1339 * MiB;
constexpr size_t WS_MBUF = WS_SEG, WS_T = WS_SEG + 2 * SEG2K, WS_X1B = WS_SEG + 4 * SEG2K;
static_assert(SEG2K == 66 * MiB && WS_SEG + 7 * SEG2K + 4 * SEG2K == WS_P && WS_H + 2 * SEG2K == WS_SEG, "ws map");
constexpr int CW_TMO = 0, CW_BAR = 4096;

#define GAS __attribute__((address_space(1)))
#define LAS __attribute__((address_space(3)))
typedef unsigned short bf16;
typedef unsigned v4u __attribute__((ext_vector_type(4)));
typedef unsigned v2u __attribute__((ext_vector_type(2)));
typedef float f32x4 __attribute__((ext_vector_type(4)));
typedef float f32x2 __attribute__((ext_vector_type(2)));
typedef float f32x16 __attribute__((ext_vector_type(16)));
typedef short bf16x8 __attribute__((ext_vector_type(8)));
typedef short s16x4 __attribute__((ext_vector_type(4)));
typedef GAS unsigned gu32;
#define RLX_AGENT __ATOMIC_RELAXED, __HIP_MEMORY_SCOPE_AGENT
#define LDS_WAIT() asm volatile("s_waitcnt lgkmcnt(0)" ::: "memory")
#define VM_WAIT() asm volatile("s_waitcnt vmcnt(0)" ::: "memory")

typedef __bf16 bf16x2_t __attribute__((ext_vector_type(2)));
__device__ __forceinline__ unsigned cvt_pk_bf16(float lo, float hi) { const f32x2 v = {lo, hi}; return __builtin_bit_cast(unsigned, __builtin_convertvector(v, bf16x2_t)); }
__device__ __forceinline__ float bf_lo(unsigned w) { return __uint_as_float(w << 16); }
__device__ __forceinline__ float bf_hi(unsigned w) { return __uint_as_float(w & 0xffff0000u); }
__device__ __forceinline__ float bf2f(bf16 b) { return __uint_as_float(((unsigned)b) << 16); }
__device__ __forceinline__ float sigmoid_f(float v) { return __builtin_amdgcn_rcpf(1.0f + __builtin_amdgcn_exp2f(-1.4426950408889634f * v)); }
__device__ __forceinline__ float silu_f(float v) { return v * sigmoid_f(v); }
__device__ __forceinline__ f32x2 gelu_pk(f32x2 v) {
    const f32x2 av = __builtin_elementwise_abs(v), d = av * 0.2316418882f + 1.0f;
    f32x2 t; t.x = __builtin_amdgcn_rcpf(d.x); t.y = __builtin_amdgcn_rcpf(d.y);
    f32x2 q = t * 0.5307027145f + (-0.7265760135f); q = q * t + 0.7107068705f; q = q * t + (-0.142248368f); q = q * t + 0.127414796f; q = q * t;
    const f32x2 s = (v * v) * (-0.72134752044f);
    f32x2 e; e.x = __builtin_amdgcn_exp2f(s.x); e.y = __builtin_amdgcn_exp2f(s.y);
    const f32x2 m = v * (q * e), r = v - m;
    f32x2 o; o.x = v.x < 0.f ? m.x : r.x; o.y = v.y < 0.f ? m.y : r.y; return o;
}
__device__ __forceinline__ float wave_sum(float v) {
#pragma unroll
    for (int o = 1; o < 64; o <<= 1) v += __shfl_xor(v, o);
    return v;
}

namespace pg8 {
#define PG8_LAS __attribute__((address_space(3)))
typedef unsigned short bf16_t;
constexpr int BM = 256, BK = 64, HALF = 128, HTB = HALF * BK * 2, STAGE_BYTES = 8 * HTB, NXCD = 8, WGM = 8;
__host__ __device__ __forceinline__ int lds_byte(int r, int c) { const int st = (r >> 4) * 2 + (c >> 5), rr = r & 15, cc = c & 31, ob = rr * 64 + cc * 2; return st * 1024 + (ob ^ (((ob >> 9) & 1) << 5)); }
__host__ __device__ __forceinline__ void stage_rc(int b, int& R, int& C) { const int st = b / 1024, sb = b % 1024, swz = sb ^ (((sb >> 9) & 1) << 5); R = (st >> 1) * 16 + swz / 64; C = (st & 1) * 32 + (swz % 64) / 2; }
__host__ __device__ __forceinline__ int perm32(int rho) { const int n = rho >> 4, i = rho & 15; return 8 * (i >> 2) + 4 * n + (i & 3); }

struct Unit { int pm, pn, seg, kind, ks, nt; const char* a; const char* b; };
struct Order {
    const bf16_t *A, *Bt, *A2, *Bt2; int lda, ldb;
    int nMf, nN, nfull, G, c, nseg, ntf, nsub, nslice, nts, pm_sub0, nf_c, sub_first = 0;
    __device__ void init(const bf16_t* A_, const bf16_t* Bt_, const bf16_t* A2_, const bf16_t* Bt2_, int lda_, int ldb_, int Mfull, int N_, int Kseg, int nseg_, int G_, int c_, int Msub, int nslice_, int pm_sub0_) {
        A = A_; Bt = Bt_; A2 = A2_; Bt2 = Bt2_; lda = lda_; ldb = ldb_; nMf = Mfull / BM; nN = N_ / BM; nfull = nMf * nN; G = G_; c = c_; nseg = nseg_; ntf = Kseg / BK;
        nslice = nslice_; nsub = (Msub / BM) * nN * nslice_; nts = nslice_ ? (Kseg * nseg_ / nslice_) / BK : 0; pm_sub0 = pm_sub0_;
        nf_c = (c < nfull) ? (nfull - c + G - 1) / G : 0;
    }
    __device__ bool next(int i_, Unit& u) const {
        int i = i_; const size_t tA = (size_t)BM * lda * 2, tB = (size_t)BM * ldb * 2;
        const int ns_c = (c < nsub) ? (nsub - c + G - 1) / G : 0;
        if (sub_first) { if (i_ < ns_c) i = nf_c * nseg + i_; else { i = i_ - ns_c; if (i >= nf_c * nseg) return false; } }
        if (i < nf_c * nseg) {
            const int r = (nseg == 2) ? (i >> 1) : i; u.seg = (nseg == 2) ? (i & 1) : 0; u.kind = 0; u.ks = 0; u.nt = ntf;
            int wgid = r * G + c; { const int q = nfull / NXCD, rr = nfull % NXCD, xcd = wgid % NXCD, off = wgid / NXCD; wgid = (xcd < rr ? xcd * (q + 1) : rr * (q + 1) + (xcd - rr) * q) + off; }
            const int nig = WGM * nN, gid = wgid / nig, fm = gid * WGM, gsz = (nMf - fm) < WGM ? (nMf - fm) : WGM;
            u.pm = fm + ((wgid % nig) % gsz); u.pn = (wgid % nig) / gsz;
            u.a = (const char*)(u.seg ? A2 : A) + (size_t)u.pm * tA; u.b = (const char*)(u.seg ? Bt2 : Bt) + (size_t)u.pn * tB; return true;
        }
        const long sidx = (long)(nf_c + (i - nf_c * nseg)) * G + c - nfull;
        if (sidx >= nsub) return false;
        const int s = (int)sidx, ks = s % nslice, tile = s / nslice, sps = nslice / nseg;
        u.kind = 1; u.ks = ks; u.nt = nts; u.pn = tile % nN; u.pm = pm_sub0 + tile / nN; u.seg = ks / sps;
        const size_t kofs = (size_t)(ks % sps) * nts * BK * 2;
        u.a = (const char*)(u.seg ? A2 : A) + (size_t)u.pm * tA + kofs; u.b = (const char*)(u.seg ? Bt2 : Bt) + (size_t)u.pn * tB + kofs; return true;
    }
};

template <class Epi, bool ALIGN_EPI = true>
__device__ __forceinline__ void gemm_phase(PG8_LAS unsigned char* lds, const Order& S, const Epi& E) {
    const int tid = threadIdx.x, wid = __builtin_amdgcn_readfirstlane(tid >> 6), lane = tid & 63, wr = wid >> 2, wc = wid & 3, fr = lane & 15, fq = lane >> 4;
    unsigned voffA[2], voffB[2];
#pragma unroll
    for (int i = 0; i < 2; ++i) { int R, C; stage_rc(tid * 16 + i * 8192, R, C); const int Rb = Epi::PERM ? ((R & ~31) + perm32(R & 31)) : R;
        voffA[i] = (unsigned)(R * S.lda + C) * 2u; voffB[i] = (unsigned)(Rb * S.ldb + C) * 2u; }
    const size_t kstep = (size_t)(BK * 2);
    const size_t hstepA = (size_t)HALF * S.lda * 2, hstepB = (size_t)HALF * S.ldb * 2;
    const unsigned ldsw = (unsigned)wid * 1024u;
    const int aoff = lds_byte(wr * 64 + fr, fq * 8), boff = lds_byte(wc * 32 + fr, fq * 8);
#define PG8_SA(b, h) (((b) * 2 + (h)) * HTB)
#define PG8_SB(b, h) ((4 + (b) * 2 + (h)) * HTB)
#define PG8_STAGE(bufoff, gbase, voff) do { _Pragma("unroll") for (int _i = 0; _i < 2; ++_i) \
        __builtin_amdgcn_global_load_lds((const unsigned*)((const char*)(gbase) + (voff)[_i]), (PG8_LAS unsigned*)(lds + (bufoff) + ldsw + _i * 8192), 16, 0, 0); } while (0)
#define PG8_LDA(dst, b, h) do { _Pragma("unroll") for (int m = 0; m < 4; ++m) _Pragma("unroll") for (int k = 0; k < 2; ++k) dst[m][k] = *(const PG8_LAS bf16x8*)(lds + PG8_SA(b, h) + aoff + m * 2048 + k * 1024); } while (0)
#define PG8_LDB(dst, b, h) do { _Pragma("unroll") for (int n = 0; n < 2; ++n) _Pragma("unroll") for (int k = 0; k < 2; ++k) dst[n][k] = *(const PG8_LAS bf16x8*)(lds + PG8_SB(b, h) + boff + n * 2048 + k * 1024); } while (0)
#define PG8_MMA(ai, bj, At, Bt) do { __builtin_amdgcn_sched_barrier(0); __builtin_amdgcn_s_setprio(1); _Pragma("unroll") for (int m = 0; m < 4; ++m) _Pragma("unroll") for (int n = 0; n < 2; ++n) _Pragma("unroll") for (int k = 0; k < 2; ++k) \
        acc[ai][bj][m][n] = __builtin_amdgcn_mfma_f32_16x16x32_bf16(Bt[n][k], At[m][k], acc[ai][bj][m][n], 0, 0, 0); __builtin_amdgcn_s_setprio(0); __builtin_amdgcn_sched_barrier(0); } while (0)
#define PG8_WAIT_V(n) asm volatile("s_waitcnt vmcnt(" #n ")" ::: "memory")
#define PG8_WAIT_L(n) asm volatile("s_waitcnt lgkmcnt(" #n ")" ::: "memory")
#define PG8_BAR __builtin_amdgcn_s_barrier()
#define PG8_SCHED __builtin_amdgcn_sched_barrier(0)
    Unit cur, nxt; int ui = 0;
    if (!S.next(0, cur)) return;
    f32x4 acc[2][2][4][2];
#pragma unroll
    for (int a = 0; a < 2; ++a)
#pragma unroll
        for (int b = 0; b < 2; ++b)
#pragma unroll
            for (int m = 0; m < 4; ++m)
#pragma unroll
                for (int n = 0; n < 2; ++n) acc[a][b][m][n] = (f32x4){0.f, 0.f, 0.f, 0.f};
    bf16x8 At[4][2], B0[2][2], B1[2][2];
    const char* cA = cur.a; const char* cB = cur.b;
    PG8_STAGE(PG8_SB(0, 0), cB, voffB); PG8_STAGE(PG8_SB(0, 1), cB + hstepB, voffB); PG8_STAGE(PG8_SA(0, 0), cA, voffA); PG8_STAGE(PG8_SA(0, 1), cA + hstepA, voffA);
    if (wr == 1) PG8_BAR;
    PG8_WAIT_V(2); PG8_BAR;
    PG8_STAGE(PG8_SB(1, 0), cB + kstep, voffB); PG8_STAGE(PG8_SA(1, 0), cA + kstep, voffA); PG8_STAGE(PG8_SB(1, 1), cB + hstepB + kstep, voffB);
    PG8_WAIT_V(6); PG8_BAR;
    for (;;) {
        const bool has_next = S.next(ui + 1, nxt);
        const char* nA = has_next ? nxt.a : cA; const char* nB = has_next ? nxt.b : cB;
        const int nt = cur.nt;
        for (int t = 0; t < nt; t += 2) {
            const bool last = (t == nt - 2);
            const char* a1 = cA + (size_t)(t + 1) * kstep;
            const char* a2 = last ? nA : cA + (size_t)(t + 2) * kstep; const char* b2 = last ? nB : cB + (size_t)(t + 2) * kstep;
            const char* a3 = a2 + kstep; const char* b3 = b2 + kstep;
            PG8_LDB(B0, 0, 0); PG8_LDB(B1, 0, 1); PG8_SCHED; PG8_LDA(At, 0, 0); PG8_STAGE(PG8_SA(1, 1), a1 + hstepA, voffA);
            PG8_WAIT_V(8); PG8_WAIT_L(0); PG8_BAR; PG8_MMA(0, 0, At, B0); PG8_MMA(0, 1, At, B1); PG8_BAR; PG8_SCHED;
            PG8_LDA(At, 0, 1); PG8_STAGE(PG8_SB(0, 0), b2, voffB); PG8_STAGE(PG8_SB(0, 1), b2 + hstepB, voffB); PG8_STAGE(PG8_SA(0, 0), a2, voffA);
            PG8_WAIT_V(8); PG8_WAIT_L(0); PG8_BAR; PG8_MMA(1, 0, At, B0); PG8_MMA(1, 1, At, B1); PG8_BAR; PG8_SCHED;
            PG8_LDB(B0, 1, 0); PG8_LDB(B1, 1, 1); PG8_SCHED; PG8_LDA(At, 1, 0); PG8_STAGE(PG8_SA(0, 1), a2 + hstepA, voffA);
            PG8_WAIT_V(8); PG8_WAIT_L(0); PG8_BAR; PG8_MMA(0, 0, At, B0); PG8_MMA(0, 1, At, B1); PG8_BAR; PG8_SCHED;
            PG8_LDA(At, 1, 1); PG8_STAGE(PG8_SB(1, 0), b3, voffB); PG8_STAGE(PG8_SB(1, 1), b3 + hstepB, voffB); PG8_STAGE(PG8_SA(1, 0), a3, voffA);
            PG8_WAIT_V(8); PG8_WAIT_L(0); PG8_BAR; PG8_MMA(1, 0, At, B0); PG8_MMA(1, 1, At, B1); PG8_BAR; PG8_SCHED;
        }
        if (ALIGN_EPI) { if (wr == 0) PG8_BAR; }
        E(acc, cur, wr, wc, fr, fq);
        if (!has_next) break;
        if (!(Epi::TWOSEG && nxt.seg == 1)) {
#pragma unroll
        for (int a = 0; a < 2; ++a)
#pragma unroll
            for (int b = 0; b < 2; ++b)
#pragma unroll
                for (int m = 0; m < 4; ++m)
#pragma unroll
                    for (int n = 0; n < 2; ++n) acc[a][b][m][n] = (f32x4){0.f, 0.f, 0.f, 0.f};
        }
        cur = nxt; cA = nA; cB = nB; ++ui;
        if (ALIGN_EPI) { if (wr == 1) PG8_BAR; }
    }
    PG8_WAIT_V(0);
    if (!ALIGN_EPI) { if (wr == 0) PG8_BAR; }
    PG8_BAR;
#undef PG8_SA
#undef PG8_SB
#undef PG8_STAGE
#undef PG8_LDA
#undef PG8_LDB
#undef PG8_MMA
#undef PG8_WAIT_V
#undef PG8_WAIT_L
#undef PG8_BAR
#undef PG8_SCHED
}

template <bool PERM_>
__device__ __forceinline__ void slab_store(const f32x4 (&acc)[2][2][4][2], const Unit& u, int wr, int wc, int fr, int fq, bf16_t* slab, int pm_sub0, const bf16_t* Gt, const bf16_t* Gt2 = nullptr) {
    const int rloc = (u.pm - pm_sub0) * BM + wr * 64 + fr, grow = u.pm * BM + wr * 64 + fr;
    bf16_t* sb = slab + (size_t)u.ks * (512 * DM);
#pragma unroll
    for (int ai = 0; ai < 2; ++ai)
#pragma unroll
        for (int m = 0; m < 4; ++m) {
#pragma unroll
            for (int bj = 0; bj < 2; ++bj) {
                if (PERM_) { const int col = u.pn * BM + bj * HALF + wc * 32 + 8 * fq; f32x4 v0 = acc[ai][bj][m][0], v1 = acc[ai][bj][m][1];
                    if (Gt) { const v4u b = *(const v4u*)(Gt + (size_t)(grow + ai * HALF + m * 16) * DM + col); v0 *= (f32x4){bf_lo(b.x), bf_hi(b.x), bf_lo(b.y), bf_hi(b.y)}; v1 *= (f32x4){bf_lo(b.z), bf_hi(b.z), bf_lo(b.w), bf_hi(b.w)}; }
                    if (Gt2) { const v4u b = *(const v4u*)(Gt2 + (size_t)(grow + ai * HALF + m * 16) * DM + col); v0 *= (f32x4){bf_lo(b.x), bf_hi(b.x), bf_lo(b.y), bf_hi(b.y)}; v1 *= (f32x4){bf_lo(b.z), bf_hi(b.z), bf_lo(b.w), bf_hi(b.w)}; }
                    v4u w; w.x = cvt_pk_bf16(v0[0], v0[1]); w.y = cvt_pk_bf16(v0[2], v0[3]); w.z = cvt_pk_bf16(v1[0], v1[1]); w.w = cvt_pk_bf16(v1[2], v1[3]);
                    *(v4u*)(sb + (size_t)(rloc + ai * HALF + m * 16) * DM + col) = w; }
                else {
#pragma unroll
                    for (int n = 0; n < 2; ++n) { const int col = u.pn * BM + bj * HALF + wc * 32 + 16 * n + 4 * fq; const f32x4 v = acc[ai][bj][m][n];
                        v2u w; w.x = cvt_pk_bf16(v[0], v[1]); w.y = cvt_pk_bf16(v[2], v[3]); *(v2u*)(sb + (size_t)(rloc + ai * HALF + m * 16) * DM + col) = w; } }
            }
            asm volatile("" ::: "memory"); }
}
struct EpiStore {
    static constexpr bool PERM = true, TWOSEG = false;
    bf16_t* O; int ldc; bf16_t* slab; int pm_sub0;
    __device__ __forceinline__ void operator()(f32x4 (&acc)[2][2][4][2], const Unit& u, int wr, int wc, int fr, int fq) const {
        if (u.kind == 1) { slab_store<true>(acc, u, wr, wc, fr, fq, slab, pm_sub0, nullptr); return; }
        const int row0 = u.pm * BM + wr * 64 + fr, col0 = u.pn * BM + wc * 32 + 8 * fq;
#pragma unroll
        for (int ai = 0; ai < 2; ++ai)
#pragma unroll
            for (int m = 0; m < 4; ++m) { bf16_t* rowp = O + (size_t)(row0 + ai * HALF + m * 16) * ldc + col0;
#pragma unroll
                for (int bj = 0; bj < 2; ++bj) { const f32x4 v0 = acc[ai][bj][m][0], v1 = acc[ai][bj][m][1];
                    v4u w; w.x = cvt_pk_bf16(v0[0], v0[1]); w.y = cvt_pk_bf16(v0[2], v0[3]); w.z = cvt_pk_bf16(v1[0], v1[1]); w.w = cvt_pk_bf16(v1[2], v1[3]);
                    *(v4u*)(rowp + bj * HALF) = w; } }
    }
};
struct EpiIn {
    static constexpr bool PERM = true, TWOSEG = false;
    bf16_t* seg0; float* out; int pmo;
    template <int ACT, bool F32OUT>
    __device__ __forceinline__ void run(const f32x4 (&acc)[2][2][4][2], bf16_t* O, int ldc, int row0, int col0, float* fo) const {
#pragma unroll
        for (int ai = 0; ai < 2; ++ai)
#pragma unroll
            for (int m = 0; m < 4; ++m) { bf16_t* rowp = O + (size_t)(row0 + ai * HALF + m * 16) * ldc + col0;
#pragma unroll
                for (int bj = 0; bj < 2; ++bj) { f32x4 v0 = acc[ai][bj][m][0], v1 = acc[ai][bj][m][1];
                    if (F32OUT) { float* fp = fo + (size_t)(ai * HALF + m * 16) * DBR + bj * HALF; *(f32x4*)fp = v0; *(f32x4*)(fp + 4) = v1; }
                    if (ACT == 1) { f32x2 a = gelu_pk((f32x2){v0[0], v0[1]}), b = gelu_pk((f32x2){v0[2], v0[3]}), c = gelu_pk((f32x2){v1[0], v1[1]}), d = gelu_pk((f32x2){v1[2], v1[3]});
                        v0 = (f32x4){a.x, a.y, b.x, b.y}; v1 = (f32x4){c.x, c.y, d.x, d.y}; }
                    if (ACT == 2) {
#pragma unroll
                        for (int j = 0; j < 4; ++j) { v0[j] = silu_f(v0[j]); v1[j] = silu_f(v1[j]); } }
                    if (ACT == 3) {
#pragma unroll
                        for (int j = 0; j < 4; ++j) { v0[j] = sigmoid_f(v0[j]); v1[j] = sigmoid_f(v1[j]); } }
                    v4u w; w.x = cvt_pk_bf16(v0[0], v0[1]); w.y = cvt_pk_bf16(v0[2], v0[3]); w.z = cvt_pk_bf16(v1[0], v1[1]); w.w = cvt_pk_bf16(v1[2], v1[3]);
                    *(v4u*)(rowp + bj * HALF) = w; } }
    }
    template <int KIND  >
    __device__ __forceinline__ void run_pair(const f32x4 (&acc)[2][2][4][2], bf16_t* O1, bf16_t* O2, int ldc, int row0, int ch0) const {
#pragma unroll
        for (int ai = 0; ai < 2; ++ai)
#pragma unroll
            for (int m = 0; m < 4; ++m) { const size_t ro = (size_t)(row0 + ai * HALF + m * 16) * ldc + ch0;
#pragma unroll
                for (int bj = 0; bj < 2; ++bj) { const f32x4 v0 = acc[ai][bj][m][0], v1 = acc[ai][bj][m][1];
                    if (KIND == 0) { const f32x2 a = gelu_pk((f32x2){v0[0], v0[1]}), b = gelu_pk((f32x2){v0[2], v0[3]});
                        v2u w; w.x = cvt_pk_bf16(a.x * silu_f(v1[0]), a.y * silu_f(v1[1])); w.y = cvt_pk_bf16(b.x * silu_f(v1[2]), b.y * silu_f(v1[3]));
                        *(v2u*)(O1 + ro + bj * (HALF / 2)) = w; }
                    else { float r[4], sb[4];
#pragma unroll
                        for (int j = 0; j < 4; ++j) { const float ea = __builtin_amdgcn_exp2f(-1.4426950408889634f * v0[j]), eb = __builtin_amdgcn_exp2f(-1.4426950408889634f * v1[j]);
                            sb[j] = __builtin_amdgcn_rcpf(1.0f + eb); r[j] = (1.0f + eb) * __builtin_amdgcn_rcpf(1.0f + ea); }
                        v2u w1, w2; w1.x = cvt_pk_bf16(r[0], r[1]); w1.y = cvt_pk_bf16(r[2], r[3]); w2.x = cvt_pk_bf16(sb[0], sb[1]); w2.y = cvt_pk_bf16(sb[2], sb[3]);
                        *(v2u*)(O1 + ro + bj * (HALF / 2)) = w1; *(v2u*)(O2 + ro + bj * (HALF / 2)) = w2; } } }
    }
    __device__ __forceinline__ void operator()(f32x4 (&acc)[2][2][4][2], const Unit& u, int wr, int wc, int fr, int fq) const {
        const int pn = u.pn, pm = u.pm + pmo, rloc = wr * 64 + fr, row0 = pm * BM + rloc;
        if (pn >= 56) { const int ch0 = (pn - 56) * HALF + wc * 16 + 4 * fq;
            run_pair<1>(acc, seg0 + (size_t)7 * M * DBR, seg0 + (size_t)7 * M * DBR + (size_t)M * DM, DM, row0, ch0); return; }
        if (pn < 16) { run_pair<0>(acc, seg0, nullptr, DBR, row0, pn * HALF + wc * 16 + 4 * fq); return; }
        if (pn < 24) { run<1, false>(acc, seg0 + (size_t)M * DBR, DBR, row0, (pn - 16) * BM + wc * 32 + 8 * fq, nullptr); return; }
        const int s = pn >> 3, col0 = (pn & 7) * BM + wc * 32 + 8 * fq; bf16_t* O = seg0 + (size_t)s * M * DBR;
        if (s == 6) { run<2, false>(acc, O, DBR, row0, col0, nullptr); return; }
        if (s == 3) { run<0, false>(acc, O, DBR, row0, col0, nullptr); return; }
        float* fo = nullptr;
        if (pm >= 64) fo = out + (s == 4 ? OFF_KS : OFF_VS) + (size_t)((pm - 64) * BM + rloc) * DBR + col0;
        else if ((pm & 7) >= 6) fo = out + (s == 4 ? OFF_KP : OFF_VP) + (size_t)((pm >> 3) * 512 + ((pm & 7) - 6) * BM + rloc) * DBR + col0;
        if (fo) run<0, true>(acc, O, DBR, row0, col0, fo); else run<0, false>(acc, O, DBR, row0, col0, nullptr);
    }
};
struct EpiMerge {
    static constexpr bool PERM = true, TWOSEG = true;
    const bf16_t* SGA; const bf16_t* SGB; bf16_t* O;
    __device__ __forceinline__ void operator()(f32x4 (&acc)[2][2][4][2], const Unit& u, int wr, int wc, int fr, int fq) const {
        const int row0 = u.pm * BM + wr * 64 + fr, col0 = u.pn * BM + wc * 32 + 8 * fq;
#define MG_OFF(it) ((size_t)(row0 + ((it) >> 2) * HALF + ((it) & 3) * 16) * DM + col0)
        if (u.seg == 0) {
            v4u ga[2][2];
            { const size_t off = MG_OFF(0); ga[0][0] = *(const v4u*)(SGA + off); ga[0][1] = *(const v4u*)(SGA + off + HALF); }
#pragma unroll
            for (int it = 0; it < 8; ++it) { const int ai = it >> 2, m = it & 3, cb = it & 1, nb = cb ^ 1;
                if (it + 1 < 8) { const size_t off = MG_OFF(it + 1); ga[nb][0] = *(const v4u*)(SGA + off); ga[nb][1] = *(const v4u*)(SGA + off + HALF); }
                asm volatile("" ::: "memory");
#pragma unroll
                for (int bj = 0; bj < 2; ++bj) { const v4u a = ga[cb][bj];
                    acc[ai][bj][m][0] *= (f32x4){bf_lo(a.x), bf_hi(a.x), bf_lo(a.y), bf_hi(a.y)}; acc[ai][bj][m][1] *= (f32x4){bf_lo(a.z), bf_hi(a.z), bf_lo(a.w), bf_hi(a.w)}; }
                asm volatile("" ::: "memory"); }
        } else {
            v4u gb[2][2];
            { const size_t off = MG_OFF(0); gb[0][0] = *(const v4u*)(SGB + off); gb[0][1] = *(const v4u*)(SGB + off + HALF); }
#pragma unroll
            for (int it = 0; it < 8; ++it) { const int ai = it >> 2, m = it & 3, cb = it & 1, nb = cb ^ 1;
                if (it + 1 < 8) { const size_t off = MG_OFF(it + 1); gb[nb][0] = *(const v4u*)(SGB + off); gb[nb][1] = *(const v4u*)(SGB + off + HALF); }
                asm volatile("" ::: "memory");
                const size_t off = MG_OFF(it);
#pragma unroll
                for (int bj = 0; bj < 2; ++bj) { const v4u b = gb[cb][bj];
                    const f32x4 v0 = acc[ai][bj][m][0] * (f32x4){bf_lo(b.x), bf_hi(b.x), bf_lo(b.y), bf_hi(b.y)}, v1 = acc[ai][bj][m][1] * (f32x4){bf_lo(b.z), bf_hi(b.z), bf_lo(b.w), bf_hi(b.w)};
                    v4u w; w.x = cvt_pk_bf16(v0[0], v0[1]); w.y = cvt_pk_bf16(v0[2], v0[3]); w.z = cvt_pk_bf16(v1[0], v1[1]); w.w = cvt_pk_bf16(v1[2], v1[3]);
                    *(v4u*)(O + off + bj * HALF) = w; }
                asm volatile("" ::: "memory"); }
        }
#undef MG_OFF
    }
};
struct EpiMergeSub {
    static constexpr bool PERM = true, TWOSEG = false;
    const bf16_t* SGA; const bf16_t* SGB; bf16_t* slab; int pm_sub0;
    __device__ __forceinline__ void operator()(f32x4 (&acc)[2][2][4][2], const Unit& u, int wr, int wc, int fr, int fq) const {
        slab_store<true>(acc, u, wr, wc, fr, fq, slab, pm_sub0, SGB, u.seg ? nullptr : SGA);
    }
};
struct EpiFinal {
    static constexpr bool PERM = false, TWOSEG = false;
    float* Y; const bf16_t* P; bf16_t* slab; int pm_sub0; const bf16_t* XB;
    __device__ __forceinline__ void operator()(f32x4 (&acc)[2][2][4][2], const Unit& u, int wr, int wc, int fr, int fq) const {
        if (u.kind == 1) { slab_store<false>(acc, u, wr, wc, fr, fq, slab, pm_sub0, nullptr); return; }
        const int row0 = u.pm * BM + wr * 64 + fr, col0 = u.pn * BM + wc * 32 + 4 * fq;
#define FN_OFF(it) ((size_t)(row0 + ((it) >> 2) * HALF + ((it) & 3) * 16) * DM + col0)
        v2u xv[2][4], pv[2][4];
        { const size_t off = FN_OFF(0);
#pragma unroll
          for (int q = 0; q < 4; ++q) { const size_t o2 = off + (q >> 1) * HALF + (q & 1) * 16; xv[0][q] = *(const v2u*)(XB + o2); pv[0][q] = *(const v2u*)(P + o2); } }
#pragma unroll
        for (int it = 0; it < 8; ++it) { const int ai = it >> 2, m = it & 3, cb = it & 1, nb = cb ^ 1;
            if (it + 1 < 8) { const size_t off = FN_OFF(it + 1);
#pragma unroll
                for (int q = 0; q < 4; ++q) { const size_t o2 = off + (q >> 1) * HALF + (q & 1) * 16; xv[nb][q] = *(const v2u*)(XB + o2); pv[nb][q] = *(const v2u*)(P + o2); } }
            asm volatile("" ::: "memory");
            const size_t off = FN_OFF(it);
#pragma unroll
            for (int q = 0; q < 4; ++q) { const int bj = q >> 1, n = q & 1; const size_t o2 = off + bj * HALF + n * 16; const v2u x1 = xv[cb][q], p = pv[cb][q]; const f32x4 a = acc[ai][bj][m][n];
                f32x4 y; y[0] = bf_lo(x1.x) + sigmoid_f(a[0]) * bf_lo(p.x); y[1] = bf_hi(x1.x) + sigmoid_f(a[1]) * bf_hi(p.x); y[2] = bf_lo(x1.y) + sigmoid_f(a[2]) * bf_lo(p.y); y[3] = bf_hi(x1.y) + sigmoid_f(a[3]) * bf_hi(p.y);
                *(f32x4*)(Y + o2) = y; }
            asm volatile("" ::: "memory"); }
#undef FN_OFF
    }
};
}

namespace att {
constexpr float SCALE = 0.08838834764831845f, THR = 8.f;
constexpr int SHM = 16384;
constexpr int OFF_V = 0, OFF_K = 2 * SHM, OFF_TAB = 4 * SHM, OFF_WS = 4 * SHM + 2048, LDS_NEED = OFF_WS + 8 * 256;
#define KSWZ(row, colB) ((row) * 256 + ((colB) ^ (((row) & 7) << 4)))
#define SBAR() __builtin_amdgcn_sched_barrier(0)
__device__ __forceinline__ int v_st(int k, int c) { const int kk = (k & ~0xC) | ((k & 4) << 1) | ((k & 8) >> 1); return ((kk >> 3) * 4 + (c >> 5)) * 512 + ((kk & 7) * 32 + (c & 31)) * 2; }
__device__ __forceinline__ int v_rd_base(int lane) { return ((lane & 3) << 3) | (((lane >> 2) & 3) << 6) | (((lane >> 4) & 1) << 5) | (((lane >> 5) & 1) << 8); }
constexpr int v_rd_off(int d0, int ks, int half) { return d0 * 512 + ks * 4096 + half * 2048; }
__device__ __forceinline__ int crow(int r, int hi) { return (r & 3) + 8 * (r >> 2) + 4 * hi; }
__device__ __forceinline__ void partialSM(f32x16& p0, f32x16& p1, float& m_reg, float& mn, float& alpha) {
    float pmax = p0[0];
#pragma unroll
    for (int r = 1; r < 16; ++r) pmax = fmaxf(pmax, p0[r]);
#pragma unroll
    for (int r = 0; r < 16; ++r) pmax = fmaxf(pmax, p1[r]);
    { auto rr = __builtin_amdgcn_permlane32_swap(__float_as_uint(pmax), __float_as_uint(pmax), false, false);
      pmax = fmaxf(__uint_as_float(rr[0]), __uint_as_float(rr[1])); }
    constexpr float C2 = 1.4426950408889634f * SCALE;
    if (__builtin_expect(__all((pmax - m_reg) * SCALE <= THR), 1)) { mn = m_reg; alpha = 1.f; }
    else { mn = fmaxf(m_reg, pmax); alpha = __builtin_amdgcn_exp2f((m_reg - mn) * C2); m_reg = mn; }
    const float mnL = -mn * C2;
#pragma unroll
    for (int r = 0; r < 16; ++r) p0[r] = fmaf(p0[r], C2, mnL);
#pragma unroll
    for (int r = 0; r < 16; ++r) p1[r] = fmaf(p1[r], C2, mnL);
#pragma unroll
    for (int r = 0; r < 16; ++r) p0[r] = __builtin_amdgcn_exp2f(p0[r]);
}
__device__ __forceinline__ void finishSM(f32x16& p0, f32x16& p1, float alpha, float& l_reg, bf16x8& pa0, bf16x8& pa1, bf16x8& pa2, bf16x8& pa3) {
#pragma unroll
    for (int r = 0; r < 16; ++r) p1[r] = __builtin_amdgcn_exp2f(p1[r]);
    float ps = 0;
#pragma unroll
    for (int r = 0; r < 16; ++r) ps += p0[r];
#pragma unroll
    for (int r = 0; r < 16; ++r) ps += p1[r];
    { auto rr = __builtin_amdgcn_permlane32_swap(__float_as_uint(ps), __float_as_uint(ps), false, false);
      ps = __uint_as_float(rr[0]) + __uint_as_float(rr[1]); }
    l_reg = l_reg * alpha + ps;
#define PK4(P, B_, OUT) do { unsigned a0 = cvt_pk_bf16(P[B_+0], P[B_+1]), a1 = cvt_pk_bf16(P[B_+2], P[B_+3]);                          \
        unsigned b0 = cvt_pk_bf16(P[B_+4], P[B_+5]), b1 = cvt_pk_bf16(P[B_+6], P[B_+7]);                                             \
        auto r0 = __builtin_amdgcn_permlane32_swap(a0, b0, false, false); auto r1 = __builtin_amdgcn_permlane32_swap(a1, b1, false, false); \
        v4u w = {r0[0], r1[0], r0[1], r1[1]}; OUT = *reinterpret_cast<bf16x8*>(&w); } while (0)
    PK4(p0, 0, pa0); PK4(p0, 8, pa1); PK4(p1, 0, pa2); PK4(p1, 8, pa3);
#undef PK4
}
template <int KB>
__device__ __forceinline__ void qkt(f32x16& p0, f32x16& p1, const char* K_lds, int r32, int hi, const bf16x8* qr) {
    const char* kb[4];
#pragma unroll
    for (int dd = 0; dd < 4; ++dd) kb[dd] = K_lds + KB * SHM + KSWZ(r32, (dd * 16 + hi * 8) * 2);
#pragma unroll
    for (int hf = 0; hf < 2; ++hf) {
        bf16x8 f0[4], f1[4];
#pragma unroll
        for (int dd = 0; dd < 4; ++dd) { const char* a = kb[dd] + hf * 128; f0[dd] = *reinterpret_cast<const bf16x8*>(a); f1[dd] = *reinterpret_cast<const bf16x8*>(a + 32 * 256); }
        asm volatile("s_waitcnt lgkmcnt(0)" ::: "memory"); SBAR();
#pragma unroll
        for (int dd = 0; dd < 4; ++dd) { p0 = __builtin_amdgcn_mfma_f32_32x32x16_bf16(f0[dd], qr[hf * 4 + dd], p0, 0, 0, 0); p1 = __builtin_amdgcn_mfma_f32_32x32x16_bf16(f1[dd], qr[hf * 4 + dd], p1, 0, 0, 0); }
    }
}
template <int VB>
__device__ __forceinline__ void pv_tile(f32x16* o, int vb0, bf16x8 pa0, bf16x8 pa1, bf16x8 pa2, bf16x8 pa3) {
#define TRRD(dst, off) asm volatile("ds_read_b64_tr_b16 %0, %1 offset:%2" : "=&v"(dst) : "v"(vb0), "i"(off) : "memory")
#define PV_KS(ks, PA) do { s16x4 l0, l1, l2, l3, h0, h1, h2, h3; constexpr int b_ = VB * SHM + v_rd_off(0, ks, 0); \
        TRRD(l0, b_); TRRD(h0, b_ + 2048); TRRD(l1, b_ + 512); TRRD(h1, b_ + 512 + 2048); TRRD(l2, b_ + 1024); TRRD(h2, b_ + 1024 + 2048); TRRD(l3, b_ + 1536); TRRD(h3, b_ + 1536 + 2048); \
        asm volatile("s_waitcnt lgkmcnt(0)" ::: "memory"); SBAR();   \
        o[0] = __builtin_amdgcn_mfma_f32_32x32x16_bf16(PA, (bf16x8){l0[0], l0[1], l0[2], l0[3], h0[0], h0[1], h0[2], h0[3]}, o[0], 0, 0, 0);   \
        o[1] = __builtin_amdgcn_mfma_f32_32x32x16_bf16(PA, (bf16x8){l1[0], l1[1], l1[2], l1[3], h1[0], h1[1], h1[2], h1[3]}, o[1], 0, 0, 0);   \
        o[2] = __builtin_amdgcn_mfma_f32_32x32x16_bf16(PA, (bf16x8){l2[0], l2[1], l2[2], l2[3], h2[0], h2[1], h2[2], h2[3]}, o[2], 0, 0, 0);   \
        o[3] = __builtin_amdgcn_mfma_f32_32x32x16_bf16(PA, (bf16x8){l3[0], l3[1], l3[2], l3[3], h3[0], h3[1], h3[2], h3[3]}, o[3], 0, 0, 0); } while (0)
    PV_KS(0, pa0); PV_KS(1, pa1); PV_KS(2, pa2); PV_KS(3, pa3);
#undef PV_KS
#undef TRRD
}

__device__ __forceinline__ void prompt_units(char* lds, const bf16* Q, const bf16* Kt, const bf16* Vt, const bf16* SZB, bf16* YB, const float* rel, int it0, int stride, int nit) {
    const int tid = threadIdx.x, wid = __builtin_amdgcn_readfirstlane(tid >> 6), lane = tid & 63, r32 = lane & 31, hi = lane >> 5;
    char* V_lds = lds + OFF_V; char* K_lds = lds + OFF_K; float* tab = (float*)(lds + OFF_TAB);
    float* wsx = (float*)(lds + OFF_WS) + wid * 64; float* li_l = wsx, * al_l = wsx + 32;
    const int sr = tid >> 4, sc = (tid & 15) * 8, vst0 = v_st(sr, sc), vst1 = v_st(32 + sr, sc), kws = KSWZ(sr, sc * 2);
    const int vb0 = (int)(uintptr_t)V_lds + v_rd_base(lane);
    const int qo = 32 * (wid & 1) + r32;
    if (it0 >= nit) return;
    bf16x8 qr[8], st_k0, st_k1, st_v0, st_v1;
#define JLO(qb_) ((4 * (qb_) - 8) > 0 ? (4 * (qb_) - 8) : 0)
#define QLOAD(b_, h_, qb_) do { const bf16* qp_ = Q + (size_t)((b_) * SEQ + (qb_) * 256 + wid * 32 + r32) * DBR + (h_) * HD; \
        _Pragma("unroll") for (int d0 = 0; d0 < 8; ++d0) qr[d0] = *reinterpret_cast<const bf16x8*>(qp_ + d0 * 16 + hi * 8); } while (0)
#define SLOAD(Kp, Vp, k0) do { st_v0 = *reinterpret_cast<const bf16x8*>((Vp) + (size_t)((k0) + sr) * DBR); st_v1 = *reinterpret_cast<const bf16x8*>((Vp) + (size_t)((k0) + 32 + sr) * DBR); \
                               st_k0 = *reinterpret_cast<const bf16x8*>((Kp) + (size_t)((k0) + sr) * DBR); st_k1 = *reinterpret_cast<const bf16x8*>((Kp) + (size_t)((k0) + 32 + sr) * DBR); } while (0)
#define SWRITE(bf) do { *(bf16x8*)(V_lds + (bf) * SHM + vst0) = st_v0; *(bf16x8*)(V_lds + (bf) * SHM + vst1) = st_v1; \
                        *(bf16x8*)(K_lds + (bf) * SHM + kws) = st_k0; *(bf16x8*)(K_lds + (bf) * SHM + kws + 32 * 256) = st_k1; } while (0)
    int it = it0, hprev = -1;
    { const int qb = it >> 7, bh = it & 127, b = bh >> 4, h = bh & 15;
      QLOAD(b, h, qb); SLOAD(Kt + (size_t)(b * SEQ) * DBR + h * HD + sc, Vt + (size_t)(b * SEQ) * DBR + h * HD + sc, JLO(qb) * 64);
      if (tid < NREL) tab[tid] = rel[h * NREL + tid] * (1.0f / SCALE); hprev = h;
      SWRITE(0); __syncthreads(); }
    for (;;) {
        const int qb = it >> 7, bh = it & 127, b = bh >> 4, h = bh & 15;
        const int rowbase = b * SEQ + qb * 256;
        const int j_lo = JLO(qb), NT = 4 * qb + 4 - j_lo;
        const int cw = 4 * qb + (wid >> 1);
        const bf16* Kh = Kt + (size_t)(b * SEQ) * DBR + h * HD + sc; const bf16* Vh = Vt + (size_t)(b * SEQ) * DBR + h * HD + sc;
        float m_reg = -1e30f, l_reg = 0.f; f32x16 o[4] = {};
        const float tab256 = tab[256];
#define STEP(t, BUF) do { \
        if ((t) + 1 < NT) SLOAD(Kh, Vh, (j_lo + (t) + 1) * 64); \
        const int cd = cw - (j_lo + (t)); \
        if (cd >= 0 && cd <= 8) { \
            f32x16 p0, p1; \
            if (cd >= 3) { _Pragma("unroll") for (int r = 0; r < 16; ++r) { p0[r] = tab256; p1[r] = tab256; } } \
            else { const int dq = 64 * cd + qo - 4 * hi + 128; \
                _Pragma("unroll") for (int r = 0; r < 16; ++r) { const int c = (r & 3) + 8 * (r >> 2); int i0 = dq - c, i1 = dq - c - 32; i0 = i0 > 256 ? 256 : i0; i1 = i1 > 256 ? 256 : i1; p0[r] = tab[i0]; p1[r] = tab[i1]; } } \
            SBAR(); qkt<BUF>(p0, p1, K_lds, r32, hi, qr); \
            float mn, al; partialSM(p0, p1, m_reg, mn, al); \
            if (__any(al < 1.f)) { if (hi == 0) al_l[r32] = al; LDS_WAIT(); \
                _Pragma("unroll") for (int d_ = 0; d_ < 4; ++d_) _Pragma("unroll") for (int r = 0; r < 16; ++r) o[d_][r] *= al_l[crow(r, hi)]; } \
            bf16x8 pa0, pa1, pa2, pa3; finishSM(p0, p1, al, l_reg, pa0, pa1, pa2, pa3); SBAR(); \
            pv_tile<BUF>(o, vb0, pa0, pa1, pa2, pa3); \
        } \
        if ((t) + 1 < NT) SWRITE((BUF) ^ 1); \
        __syncthreads(); } while (0)
        for (int t = 0; t < NT; t += 2) { STEP(t, 0); STEP(t + 1, 1); }
#undef STEP
        const int itn = it + stride; const bool more = itn < nit;
        if (more) { const int qbn = itn >> 7, bhn = itn & 127, bn = bhn >> 4, hn = bhn & 15;
            QLOAD(bn, hn, qbn); SLOAD(Kt + (size_t)(bn * SEQ) * DBR + hn * HD + sc, Vt + (size_t)(bn * SEQ) * DBR + hn * HD + sc, JLO(qbn) * 64); }
        if (hi == 0) li_l[r32] = l_reg; LDS_WAIT();
        float rli[16];
#pragma unroll
        for (int r = 0; r < 16; ++r) rli[r] = __builtin_amdgcn_rcpf(li_l[crow(r, hi)]);
        const int odd = r32 & 1;
        unsigned zp[16][2];
#pragma unroll
        for (int r = 0; r < 16; ++r) { const size_t go = (size_t)(rowbase + wid * 32 + crow(r, hi)) * DBR + h * HD + (r32 - odd) + odd * 32;
#pragma unroll
            for (int p = 0; p < 2; ++p) zp[r][p] = *(const unsigned*)(SZB + go + p * 64); }
#pragma unroll
        for (int r = 0; r < 16; ++r) { const size_t go = (size_t)(rowbase + wid * 32 + crow(r, hi)) * DBR + h * HD + (r32 - odd) + odd * 32;
#pragma unroll
            for (int p = 0; p < 2; ++p) { const float va = o[2 * p][r] * rli[r], vb = o[2 * p + 1][r] * rli[r];
                const float keep = odd ? vb : va, recv = __shfl_xor(odd ? va : vb, 1);
                const float lo = odd ? recv : keep, hi_ = odd ? keep : recv;
                *(unsigned*)(YB + go + p * 64) = cvt_pk_bf16(lo * bf_lo(zp[r][p]), hi_ * bf_hi(zp[r][p])); } }
        __syncthreads();
        if (!more) break;
        { const int hn = (itn & 127) & 15; if (hn != hprev) { if (tid < NREL) tab[tid] = rel[hn * NREL + tid] * (1.0f / SCALE); hprev = hn; } }
        SWRITE(0);
        __syncthreads();
        it = itn;
    }
#undef JLO
#undef QLOAD
#undef SLOAD
#undef SWRITE
}

constexpr int S_OFF_P = 0, S_OFF_ML = 8 * 80 * 16 * 4, S_OFF_OW = S_OFF_ML + 8 * 32 * 4 + 0, S_LDS_NEED = S_OFF_OW + 8 * 16 * 128 * 4;
__device__ __forceinline__ void sample_unit(char* lds, const bf16* Q, const bf16* Kt, const bf16* Vt, const bf16* SZB, bf16* YB, const float* ck, const float* cv, const float* rel, int b, int h) {
    const int tid = threadIdx.x, wid = __builtin_amdgcn_readfirstlane(tid >> 6), lane = tid & 63, l15 = lane & 15, kq = lane >> 4;
    float* Pw = (float*)(lds + S_OFF_P) + wid * 80 * 16; float* ML = (float*)(lds + S_OFF_ML); float* OW = (float*)(lds + S_OFF_OW);
    const int rowbase = MP + b * DECT;
    constexpr float L2E = 1.4426950408889634f;
    bf16x8 qf[4];
#pragma unroll
    for (int ks = 0; ks < 4; ++ks) qf[ks] = *reinterpret_cast<const bf16x8*>(Q + (size_t)(rowbase + l15) * DBR + h * HD + ks * 32 + kq * 8);
    const float* relh = rel + h * NREL;
    const int nblk = (wid == 0) ? 5 : 4;
    float sc[5][4];
#pragma unroll
    for (int kb = 0; kb < 5; ++kb) { if (kb < nblk) {
        f32x4 acc = {0.f, 0.f, 0.f, 0.f};
        if (kb < 4) { const float* kp = ck + ((size_t)(b * CACHE + wid * 64 + kb * 16 + l15) * NH + h) * HD + kq * 8;
#pragma unroll
            for (int ks = 0; ks < 4; ++ks) { const f32x4 x0 = *(const f32x4*)(kp + ks * 32), x1 = *(const f32x4*)(kp + ks * 32 + 4);
                v4u w = {cvt_pk_bf16(x0[0], x0[1]), cvt_pk_bf16(x0[2], x0[3]), cvt_pk_bf16(x1[0], x1[1]), cvt_pk_bf16(x1[2], x1[3])};
                acc = __builtin_amdgcn_mfma_f32_16x16x32_bf16(*reinterpret_cast<bf16x8*>(&w), qf[ks], acc, 0, 0, 0); } }
        else { const bf16* kp = Kt + (size_t)(rowbase + l15) * DBR + h * HD + kq * 8;
#pragma unroll
            for (int ks = 0; ks < 4; ++ks) acc = __builtin_amdgcn_mfma_f32_16x16x32_bf16(*reinterpret_cast<const bf16x8*>(kp + ks * 32), qf[ks], acc, 0, 0, 0); }
#pragma unroll
        for (int i = 0; i < 4; ++i) { int d;
            if (kb < 4) d = l15 + CACHE - (wid * 64 + kb * 16 + 4 * kq + i); else d = l15 - (4 * kq + i);
            d = d > 128 ? 128 : d; sc[kb][i] = (acc[i] * SCALE + relh[d + 128]) * L2E; }
    } else {
#pragma unroll
        for (int i = 0; i < 4; ++i) sc[kb][i] = -1e30f; } }
    float mx = -1e30f;
#pragma unroll
    for (int kb = 0; kb < 5; ++kb)
#pragma unroll
        for (int i = 0; i < 4; ++i) mx = fmaxf(mx, sc[kb][i]);
    mx = fmaxf(mx, __shfl_xor(mx, 16)); mx = fmaxf(mx, __shfl_xor(mx, 32));
    float ls = 0.f;
#pragma unroll
    for (int kb = 0; kb < 5; ++kb)
#pragma unroll
        for (int i = 0; i < 4; ++i) { const float p = (kb < nblk) ? __builtin_amdgcn_exp2f(sc[kb][i] - mx) : 0.f; ls += p; if (kb < nblk) Pw[(kb * 16 + 4 * kq + i) * 16 + l15] = p; }
    ls += __shfl_xor(ls, 16); ls += __shfl_xor(ls, 32);
    if (kq == 0) { ML[wid * 32 + l15] = mx; ML[wid * 32 + 16 + l15] = ls; }
    LDS_WAIT();
    f32x2 ov[16];
#pragma unroll
    for (int q = 0; q < 16; ++q) ov[q] = (f32x2){0.f, 0.f};
    const float* vp = cv + ((size_t)(b * CACHE + wid * 64) * NH + h) * HD + 2 * lane;
#pragma unroll 4
    for (int k = 0; k < 64; ++k) { const f32x2 v = *(const f32x2*)(vp + (size_t)k * NH * HD); const f32x4* pr = (const f32x4*)(Pw + k * 16);
#pragma unroll
        for (int q4 = 0; q4 < 4; ++q4) { const f32x4 p = pr[q4];
            ov[4 * q4 + 0] += v * p[0]; ov[4 * q4 + 1] += v * p[1]; ov[4 * q4 + 2] += v * p[2]; ov[4 * q4 + 3] += v * p[3]; } }
    if (wid == 0) {
        for (int k = 0; k < 16; ++k) { const unsigned vw = *(const unsigned*)(Vt + (size_t)(rowbase + k) * DBR + h * HD + 2 * lane); const f32x2 v = {bf_lo(vw), bf_hi(vw)}; const f32x4* pr = (const f32x4*)(Pw + (64 + k) * 16);
#pragma unroll
            for (int q4 = 0; q4 < 4; ++q4) { const f32x4 p = pr[q4];
                ov[4 * q4 + 0] += v * p[0]; ov[4 * q4 + 1] += v * p[1]; ov[4 * q4 + 2] += v * p[2]; ov[4 * q4 + 3] += v * p[3]; } }
    }
#pragma unroll
    for (int q = 0; q < 16; ++q) *(f32x2*)(OW + (wid * 16 + q) * 128 + 2 * lane) = ov[q];
    __syncthreads();
    { const int q = tid >> 5, d = (tid & 31) * 4; float mw[8], Mx = -1e30f;
#pragma unroll
      for (int w = 0; w < 8; ++w) { mw[w] = ML[w * 32 + q]; Mx = fmaxf(Mx, mw[w]); }
      float L = 0.f; f32x4 a = {0.f, 0.f, 0.f, 0.f};
#pragma unroll
      for (int w = 0; w < 8; ++w) { const float e = __builtin_amdgcn_exp2f(mw[w] - Mx); L += e * ML[w * 32 + 16 + q]; a += *(const f32x4*)(OW + (w * 16 + q) * 128 + d) * e; }
      const float rl = 1.0f / L; const size_t go = (size_t)(rowbase + q) * DBR + h * HD + d;
      const v2u z = *(const v2u*)(SZB + go);
      v2u w2; w2.x = cvt_pk_bf16(a[0] * rl * bf_lo(z.x), a[1] * rl * bf_hi(z.x)); w2.y = cvt_pk_bf16(a[2] * rl * bf_lo(z.y), a[3] * rl * bf_hi(z.y));
      *(v2u*)(YB + go) = w2; }
    __syncthreads();
}
}

namespace sgu {
constexpr int PITCH = 272;
constexpr int OFF_VNT = 0, OFF_W = 256 * PITCH, LDS_NEED = OFF_W + 128 * PITCH;
__device__ __forceinline__ void prompt_unit(LAS unsigned char* lds, const bf16* VN, const bf16* UZ, bf16* YA, const bf16* Wm, const float* bs, int b, int n, int g) {
    const int tid = threadIdx.x, wid = __builtin_amdgcn_readfirstlane(tid >> 6), lane = tid & 63, r32 = lane & 31, hi = lane >> 5;
    const int row0 = b * SEQ + n * GCH, c0 = g * GDIM;
#pragma unroll
    for (int it = 0; it < 4; ++it) { const int p = tid + it * 512, r = p >> 4, cpc = p & 15;
        *(LAS v4u*)(lds + OFF_W + r * PITCH + cpc * 16) = *(const v4u*)(Wm + (size_t)g * GCH * GCH + r * GCH + cpc * 8); }
#pragma unroll
    for (int it = 0; it < 4; ++it) { const int cg = wid * 4 + it, jj = lane;
        const v4u a = *(const v4u*)(VN + (size_t)(row0 + 2 * jj) * DBR + c0 + cg * 8), bb = *(const v4u*)(VN + (size_t)(row0 + 2 * jj + 1) * DBR + c0 + cg * 8);
        LAS unsigned char* dst = lds + OFF_VNT + (cg * 8) * PITCH + jj * 4;
        *(LAS unsigned*)(dst + 0 * PITCH) = (a.x & 0xffffu) | (bb.x << 16); *(LAS unsigned*)(dst + 1 * PITCH) = (a.x >> 16) | (bb.x & 0xffff0000u);
        *(LAS unsigned*)(dst + 2 * PITCH) = (a.y & 0xffffu) | (bb.y << 16); *(LAS unsigned*)(dst + 3 * PITCH) = (a.y >> 16) | (bb.y & 0xffff0000u);
        *(LAS unsigned*)(dst + 4 * PITCH) = (a.z & 0xffffu) | (bb.z << 16); *(LAS unsigned*)(dst + 5 * PITCH) = (a.z >> 16) | (bb.z & 0xffff0000u);
        *(LAS unsigned*)(dst + 6 * PITCH) = (a.w & 0xffffu) | (bb.w << 16); *(LAS unsigned*)(dst + 7 * PITCH) = (a.w >> 16) | (bb.w & 0xffff0000u); }
    __syncthreads();
    f32x16 acc[4] = {};
#pragma unroll
    for (int ks = 0; ks < 8; ++ks) {
        const bf16x8 a = *(const LAS bf16x8*)(lds + OFF_VNT + (wid * 32 + r32) * PITCH + (ks * 16 + hi * 8) * 2);
#pragma unroll
        for (int ib = 0; ib < 4; ++ib) { if (ib < 2 && ks >= 4) continue;
            const bf16x8 w = *(const LAS bf16x8*)(lds + OFF_W + (ib * 32 + r32) * PITCH + (ks * 16 + hi * 8) * 2);
            acc[ib] = __builtin_amdgcn_mfma_f32_32x32x16_bf16(a, w, acc[ib], 0, 0, 0); } }
    v2u uu[4][4]; float bsv[4];
#pragma unroll
    for (int ib = 0; ib < 4; ++ib) { const int i = ib * 32 + r32; bsv[ib] = bs[g * GCH + i]; const size_t ro = (size_t)(row0 + i) * DBR + c0 + wid * 32 + 4 * hi;
#pragma unroll
        for (int rq = 0; rq < 4; ++rq) uu[ib][rq] = *(const v2u*)(UZ + ro + 8 * rq); }
#pragma unroll
    for (int ib = 0; ib < 4; ++ib) { const int i = ib * 32 + r32; const float bsi = bsv[ib]; const size_t ro = (size_t)(row0 + i) * DBR + c0 + wid * 32 + 4 * hi;
#pragma unroll
        for (int rq = 0; rq < 4; ++rq) { const size_t go = ro + 8 * rq; const v2u u2 = uu[ib][rq];
            const float y0 = bf_lo(u2.x) * (acc[ib][4 * rq + 0] + bsi), y1 = bf_hi(u2.x) * (acc[ib][4 * rq + 1] + bsi);
            const float y2 = bf_lo(u2.y) * (acc[ib][4 * rq + 2] + bsi), y3 = bf_hi(u2.y) * (acc[ib][4 * rq + 3] + bsi);
            v2u w2; w2.x = cvt_pk_bf16(y0, y1); w2.y = cvt_pk_bf16(y2, y3); *(v2u*)(YA + go) = w2; } }
    __syncthreads();
}
__device__ __forceinline__ void sample_unit(const bf16* VN, const bf16* UZ, bf16* YA, const float* w_s, const float* bs, int b, int iq) {
    const int tid = threadIdx.x, c = tid * 4, g = c >> 8; const int row0 = MP + b * DECT;
    f32x4 v[16];
#pragma unroll
    for (int j = 0; j < 16; ++j) { const v2u x = *(const v2u*)(VN + (size_t)(row0 + j) * DBR + c); v[j] = (f32x4){bf_lo(x.x), bf_hi(x.x), bf_lo(x.y), bf_hi(x.y)}; }
    v2u uq[4];
#pragma unroll
    for (int ii = 0; ii < 4; ++ii) { const size_t go = (size_t)(row0 + iq * 4 + ii) * DBR + c; uq[ii] = *(const v2u*)(UZ + go); }
#pragma unroll
    for (int ii = 0; ii < 4; ++ii) { const int i = iq * 4 + ii; const float* wr = w_s + ((size_t)g * GCH + i) * GCH; const float bsi = bs[g * GCH + i]; f32x4 a = {bsi, bsi, bsi, bsi};
        const size_t go = (size_t)(row0 + i) * DBR + c; const v2u u2 = uq[ii];
#pragma unroll
        for (int j = 0; j < 16; ++j) a += v[j] * wr[j];
        v2u w2; w2.x = cvt_pk_bf16(bf_lo(u2.x) * a[0], bf_hi(u2.x) * a[1]); w2.y = cvt_pk_bf16(bf_lo(u2.y) * a[2], bf_hi(u2.y) * a[3]);
        *(v2u*)(YA + go) = w2; }
}
}

constexpr int NWAVES = 8;
constexpr int N_PHASES = 8;
constexpr int N_LAUNCHES = MK_N_LAUNCHES;
constexpr int RING_OFF = 0, RING_BYTES = 131072;
constexpr int LDSCTL_OFF = 143360, MISC_OFF = LDSCTL_OFF + 320;
constexpr int LDS_BYTES = 147456;
static_assert(att::LDS_NEED <= LDSCTL_OFF && att::S_LDS_NEED <= LDSCTL_OFF && sgu::LDS_NEED <= LDSCTL_OFF && 8 * 64 * 65 * 4 <= LDSCTL_OFF && MISC_OFF + 128 <= LDS_BYTES, "LDS map");

#define XB_TMO      128
#define XB_XCNT(j)  (256  + 64 * (j))
#define XB_XSUB(j)  (1280 + 64 * (j))
#define XB_XGEN(j)  (2304 + 64 * (j))
#define XB_TOP      3328
#define XB_TOPGEN   3392
#define XCD_BAR_WORDS 3456
#define XB_SPIN_CAP (1u << 18)
__device__ __forceinline__ unsigned xb_ld(unsigned* p)              { return __hip_atomic_load(p, __ATOMIC_RELAXED, __HIP_MEMORY_SCOPE_AGENT); }
__device__ __forceinline__ unsigned xb_add(unsigned* p, unsigned v) { return __hip_atomic_fetch_add(p, v, __ATOMIC_RELAXED, __HIP_MEMORY_SCOPE_AGENT); }
__device__ __forceinline__ unsigned xb_xcc_id() { return (unsigned)__builtin_amdgcn_s_getreg((3 << 11) | 20) & 0xFu; }
#define XB_SPIN(cond, bar) do { unsigned _sp = 0; while (cond) { __builtin_amdgcn_s_sleep(1); \
    if ((++_sp & 255u) == 0u) { if (xb_ld(&(bar)[XB_TMO])) break; if (_sp > XB_SPIN_CAP) { atomicAdd(&(bar)[XB_TMO], 1u); break; } } } } while (0)
struct XcdBarrier { unsigned* bar; unsigned x; volatile LAS unsigned* st; };
__device__ __forceinline__ XcdBarrier xcd_barrier_post(unsigned* bar, volatile LAS unsigned* st) {
    XcdBarrier b; b.bar = bar; b.x = xb_xcc_id(); b.st = st;
    if (threadIdx.x == 0) (void)xb_add(&bar[XB_XCNT(b.x)], 1u);
    return b;
}
__device__ __forceinline__ void xcd_barrier_complete(unsigned* bar, unsigned x, unsigned& nloc, unsigned& nx) {
    const unsigned G = gridDim.x * gridDim.y * gridDim.z;
    unsigned sum, cnt, mine, sp = 0u;
    for (;;) {
        sum = 0u; cnt = 0u; mine = 0u;
#pragma unroll
        for (unsigned j = 0; j < 16; ++j) { const unsigned c = xb_ld(&bar[XB_XCNT(j)]); sum += c; cnt += (c > 0u) ? 1u : 0u; mine = (j == x) ? c : mine; }
        if (sum == G) break;
        __builtin_amdgcn_s_sleep(1);
        if ((++sp & 255u) == 0u) { if (xb_ld(&bar[XB_TMO])) break; if (sp > XB_SPIN_CAP) { atomicAdd(&bar[XB_TMO], 1u); break; } }
    }
    nloc = mine > 0u ? mine : 1u; nx = cnt > 0u ? cnt : 1u;
}
__device__ __forceinline__ void xcd_barrier(const XcdBarrier& b) {
    asm volatile("s_waitcnt vmcnt(0)" ::: "memory");
    __syncthreads();
    if (threadIdx.x == 0) {
        unsigned* bar = b.bar;
        __builtin_amdgcn_s_waitcnt(0);
        unsigned nloc = b.st[0], nx = b.st[1];
        if (nloc == 0u) { xcd_barrier_complete(bar, b.x, nloc, nx); b.st[0] = nloc; b.st[1] = nx; }
        const unsigned old = xb_add(&bar[XB_XSUB(b.x)], 1u);
        const unsigned gen = old / nloc;
        if (old + 1u == (gen + 1u) * nloc) {
            __builtin_amdgcn_fence(__ATOMIC_RELEASE, "agent");
            asm volatile("s_waitcnt vmcnt(0)" ::: "memory");
            const unsigned og = xb_add(&bar[XB_TOP], 1u);
            const unsigned tg = og / nx;
            if (og + 1u == (tg + 1u) * nx) xb_add(&bar[XB_TOPGEN], 1u);
            else XB_SPIN(xb_ld(&bar[XB_TOPGEN]) == tg, bar);
            __builtin_amdgcn_fence(__ATOMIC_ACQUIRE, "agent");
            xb_add(&bar[XB_XGEN(b.x)], 1u);
            asm volatile("s_waitcnt vmcnt(0)" ::: "memory");
        } else {
            XB_SPIN(xb_ld(&bar[XB_XGEN(b.x)]) == gen, bar);
            __builtin_amdgcn_fence(__ATOMIC_ACQUIRE, "agent");
            asm volatile("s_waitcnt vmcnt(0)" ::: "memory");
        }
    }
    __syncthreads();
}

__device__ __forceinline__ int win_src_col(int np) {
    if (np < 2 * DBR) { const int c4 = np >> 3, e = np & 3, hf = (np >> 2) & 1; return (hf ? 2 * DBR : 0) + 4 * c4 + e; }
    if (np < 3 * DBR) return np - 2 * DBR + DBR;
    if (np < 7 * DBR) return np;
    { const int m = np - 7 * DBR, c4 = m >> 3, e = m & 3, hf = (m >> 2) & 1; return 7 * DBR + (hf ? DM : 0) + 4 * c4 + e; }
}
template <bool PERMC>
__device__ __forceinline__ void transpose_item(const float* W, int K, int N, bf16* WT, LAS float* scr, int item, int lane) {
    const int nblk = N / 64, kb = item / nblk, nb = item % nblk, k0 = 64 * kb, n0 = 64 * nb;
    const float* src = W + (size_t)k0 * N + (PERMC ? win_src_col(n0 + lane) : n0 + lane);
    float v[64];
#pragma unroll
    for (int i = 0; i < 64; ++i) v[i] = src[(size_t)i * N];
#pragma unroll
    for (int i = 0; i < 64; ++i) scr[i * 65 + lane] = v[i];
    LDS_WAIT(); asm volatile("" ::: "memory");
    const int c = lane & 7;
#pragma unroll
    for (int j = 0; j < 8; ++j) { const int n = (lane >> 3) + 8 * j; const LAS float* s = scr + (8 * c) * 65 + n;
        v4u o; o.x = cvt_pk_bf16(s[0 * 65], s[1 * 65]); o.y = cvt_pk_bf16(s[2 * 65], s[3 * 65]); o.z = cvt_pk_bf16(s[4 * 65], s[5 * 65]); o.w = cvt_pk_bf16(s[6 * 65], s[7 * 65]);
        *(v4u*)(WT + (size_t)(n0 + n) * K + k0 + 8 * c) = o; }
    LDS_WAIT(); asm volatile("" ::: "memory");
}
#define RMS_LOAD(V, xrow_) do { const f32x4* xr_ = (const f32x4*)(xrow_) + lane; _Pragma("unroll") for (int j = 0; j < 16; ++j) V[j] = xr_[64 * j]; } while (0)
#define RMS_PROC(V, orow_) do { float s_ = 0.f; _Pragma("unroll") for (int j = 0; j < 16; ++j) s_ += (V[j].x * V[j].x + V[j].y * V[j].y) + (V[j].z * V[j].z + V[j].w * V[j].w); \
        const float r_ = 1.0f / sqrtf(wave_sum(s_) * (1.f / DM) + EPS); v2u* o8_ = (v2u*)(orow_) + lane; \
        _Pragma("unroll") for (int j = 0; j < 16; ++j) { const f32x4 gg = ((const LAS f32x4*)gl)[lane + 64 * j]; v2u w; w.x = cvt_pk_bf16(V[j].x * r_ * gg.x, V[j].y * r_ * gg.y); w.y = cvt_pk_bf16(V[j].z * r_ * gg.z, V[j].w * r_ * gg.w); o8_[64 * j] = w; } } while (0)

struct Args { const float* in[19]; float* out; unsigned char* ws; int ph_lo, ph_hi, li, pad; };

__global__ void __launch_bounds__(NWAVES * 64, 2) fwd_kernel(Args args) {
    extern __shared__ __attribute__((aligned(16))) unsigned char lds_raw[];
    LAS unsigned char* lds = (LAS unsigned char*)lds_raw;
    const int tid = threadIdx.x, lane = tid & 63, wave = __builtin_amdgcn_readfirstlane(tid >> 6);
    const int G = gridDim.x, bx = blockIdx.x;
    const int vcu = (G % 8 == 0) ? (bx % 8) * (G / 8) + bx / 8 : bx;
    unsigned char* ws = args.ws;
    gu32* ctl = (gu32*)(ws + WS_CTL);
    const float* x_prompt = args.in[0]; const float* x_sample = args.in[1]; const float* cache_k = args.in[2]; const float* cache_v = args.in[3];
    const float* p_prompt = args.in[4]; const float* p_sample = args.in[5]; const float* pre_g = args.in[6]; const float* post_g = args.in[7];
    const float* w_in = args.in[8]; const float* ln_g = args.in[9]; const float* ln_b = args.in[10]; const float* w_s = args.in[11]; const float* b_s = args.in[12];
    const float* rel_bias = args.in[13]; const float* w_up_a = args.in[14]; const float* w_up_b = args.in[15]; const float* w_out = args.in[16];
    const float* w_pg = args.in[17]; const float* w_pp = args.in[18];
    float* out = args.out;
    bf16* WIN_T = (bf16*)(ws + WS_WIN); bf16* WUA_T = (bf16*)(ws + WS_WUA); bf16* WUB_T = (bf16*)(ws + WS_WUB); bf16* WOUT_T = (bf16*)(ws + WS_WOUT);
    bf16* WPG_T = (bf16*)(ws + WS_WPG); bf16* WPP_T = (bf16*)(ws + WS_WPP); bf16* WSM = (bf16*)(ws + WS_WS); bf16* PB = (bf16*)(ws + WS_PB);
    bf16* HB = (bf16*)(ws + WS_H); bf16* YA = (bf16*)(ws + WS_H); bf16* YB = (bf16*)(ws + WS_H + SEG2K);
    bf16* SEG = (bf16*)(ws + WS_SEG);
    bf16* GU = SEG; bf16* GV = SEG + (size_t)M * DBR; bf16* SZA = SEG + (size_t)2 * M * DBR; bf16* QB = SEG + (size_t)3 * M * DBR; bf16* KB = SEG + (size_t)4 * M * DBR;
    bf16* VB = SEG + (size_t)5 * M * DBR; bf16* SZB = SEG + (size_t)6 * M * DBR; bf16* SGA = SEG + (size_t)7 * M * DBR; bf16* SGB = SGA + (size_t)M * DM;
    bf16* SLAB = (bf16*)(ws + WS_SLAB); bf16* PBUF = (bf16*)(ws + WS_P); bf16* MBUF = (bf16*)(ws + WS_MBUF); bf16* TB = (bf16*)(ws + WS_T); bf16* X1B = (bf16*)(ws + WS_X1B);

    for (int u = tid; u < (LDS_BYTES - LDSCTL_OFF) / 4; u += NWAVES * 64) ((LAS unsigned*)(lds + LDSCTL_OFF))[u] = 0u;
    __syncthreads();
    volatile LAS unsigned* MISC = (volatile LAS unsigned*)(lds + MISC_OFF);
    XcdBarrier bar; bar.bar = (unsigned*)(ctl + CW_BAR); bar.x = 0; bar.st = nullptr;
    if (N_LAUNCHES == 1) bar = xcd_barrier_post((unsigned*)(ctl + CW_BAR), MISC + 8);
#define GRID_BAR() do { if (N_LAUNCHES == 1) xcd_barrier(bar); } while (0)
    const int lo = args.ph_lo, hi = args.ph_hi;
#define IN(k) (lo <= (k) && (k) < hi)
#define BOTH(k) (IN(k) && IN((k) + 1))
    const int gw = vcu * NWAVES + wave, NGW = G * NWAVES;

    if (IN(0)) {
        LAS float* scr = (LAS float*)(lds + wave * (64 * 65 * 4));
        constexpr int I_IN = (DM / 64) * (NIN / 64), I_UP = (DBR / 64) * (DM / 64), I_SQ = (DM / 64) * (DM / 64), I_PP = (PLE / 64) * (DM / 64);
        constexpr int NITEMS = I_IN + 2 * I_UP + 2 * I_SQ + I_PP;
        for (int it = gw; it < NITEMS; it += NGW) {
            int r = it;
            if (r < I_IN) { transpose_item<true>(w_in, DM, NIN, WIN_T, scr, r, lane); continue; } r -= I_IN;
            if (r < I_UP) { transpose_item<false>(w_up_a, DBR, DM, WUA_T, scr, r, lane); continue; } r -= I_UP;
            if (r < I_UP) { transpose_item<false>(w_up_b, DBR, DM, WUB_T, scr, r, lane); continue; } r -= I_UP;
            if (r < I_SQ) { transpose_item<false>(w_out, DM, DM, WOUT_T, scr, r, lane); continue; } r -= I_SQ;
            if (r < I_SQ) { transpose_item<false>(w_pg, DM, DM, WPG_T, scr, r, lane); continue; } r -= I_SQ;
            transpose_item<false>(w_pp, PLE, DM, WPP_T, scr, r, lane);
        }
        { __syncthreads();
          LAS float* gl = (LAS float*)lds;
          for (int i = tid; i < DM / 4; i += NWAVES * 64) ((LAS f32x4*)gl)[i] = ((const f32x4*)pre_g)[i];
          __syncthreads();
#define XROW(m_) ((m_) < MP ? x_prompt + (size_t)(m_) * DM : x_sample + (size_t)((m_) - MP) * DM)
          const int m0 = (NGW == 2048 ? ((gw + 1024) & 2047) : gw);
          f32x4 va[16], vb[16];
          if (m0 < M) RMS_LOAD(va, XROW(m0));
          for (int m = m0; m < M; m += 2 * NGW) {
              if (m + NGW < M) RMS_LOAD(vb, XROW(m + NGW));
              asm volatile("" ::: "memory");
              RMS_PROC(va, HB + (size_t)m * DM);
              if (m + NGW < M) { if (m + 2 * NGW < M) RMS_LOAD(va, XROW(m + 2 * NGW));
                  asm volatile("" ::: "memory");
                  RMS_PROC(vb, HB + (size_t)(m + NGW) * DM); } }
#undef XROW
        }
        { const int gt = vcu * 512 + tid, NT_ = G * 512;
          for (int i = gt; i < M * PLE / 4; i += NT_) { const int m = (i * 4) / PLE; const f32x4 v = (m < MP) ? ((const f32x4*)p_prompt)[i] : ((const f32x4*)p_sample)[i - MP * PLE / 4];
              v2u w; w.x = cvt_pk_bf16(v.x, v.y); w.y = cvt_pk_bf16(v.z, v.w); ((v2u*)PB)[i] = w; }
          for (int i = gt; i < NGRP * GCH * GCH; i += NT_) { const int ii = (i >> 7) & 127, jj = i & 127; const float v = ((jj >> 6) <= (ii >> 6)) ? w_s[i] : 0.f; WSM[i] = (bf16)(cvt_pk_bf16(v, 0.f) & 0xffffu); } }
        if (BOTH(0)) GRID_BAR();
    }
    if (IN(1)) {
#pragma unroll 1
        for (int pass = 0; pass < 2; ++pass) {
            const int pmo = pass ? MP / 256 : 0; const bf16* Ap = HB + (size_t)pmo * 256 * DM;
            pg8::Order S; S.init(Ap, WIN_T, Ap, WIN_T, DM, DM, pass ? MS : MP, NIN, DM, 1, G, bx, 0, 0, 0);
            pg8::EpiIn E{SEG, out, pmo};
            pg8::gemm_phase<pg8::EpiIn, false>(lds + RING_OFF, S, E);
        }
        if (BOTH(1)) GRID_BAR();
    }
    if (IN(2)) {
        f32x4 lg[4][2], lb[4][2];
#pragma unroll
        for (int j = 0; j < 4; ++j) { const int c = (lane + 64 * j) * 8; lg[j][0] = *(const f32x4*)(ln_g + c); lg[j][1] = *(const f32x4*)(ln_g + c + 4); lb[j][0] = *(const f32x4*)(ln_b + c); lb[j][1] = *(const f32x4*)(ln_b + c + 4); }
        for (int m = gw; m < M; m += NGW) {
            v4u* rp = (v4u*)(GV + (size_t)m * DBR) + lane;
            float v[32]; float s = 0.f;
#pragma unroll
            for (int j = 0; j < 4; ++j) { const v4u w = rp[64 * j]; v[8 * j + 0] = bf_lo(w.x); v[8 * j + 1] = bf_hi(w.x); v[8 * j + 2] = bf_lo(w.y); v[8 * j + 3] = bf_hi(w.y);
                v[8 * j + 4] = bf_lo(w.z); v[8 * j + 5] = bf_hi(w.z); v[8 * j + 6] = bf_lo(w.w); v[8 * j + 7] = bf_hi(w.w); }
#pragma unroll
            for (int j = 0; j < 32; ++j) s += v[j];
            const float mean = wave_sum(s) * (1.f / DBR); float s2 = 0.f;
#pragma unroll
            for (int j = 0; j < 32; ++j) { v[j] -= mean; s2 += v[j] * v[j]; }
            const float rstd = 1.0f / sqrtf(wave_sum(s2) * (1.f / DBR) + EPS);
            float* fo = nullptr;
            if (m >= MP) fo = out + OFF_GS + (size_t)(m - MP) * DBR; else if ((m & (SEQ - 1)) >= SEQ - GCH) fo = out + OFF_GP + (size_t)((m >> 11) * GCH + (m & (SEQ - 1)) - (SEQ - GCH)) * DBR;
#pragma unroll
            for (int j = 0; j < 4; ++j) { const int c = (lane + 64 * j) * 8; const f32x4 g0 = lg[j][0], g1 = lg[j][1], b0 = lb[j][0], b1 = lb[j][1];
                f32x4 y0, y1; y0[0] = v[8 * j + 0] * rstd * g0[0] + b0[0]; y0[1] = v[8 * j + 1] * rstd * g0[1] + b0[1]; y0[2] = v[8 * j + 2] * rstd * g0[2] + b0[2]; y0[3] = v[8 * j + 3] * rstd * g0[3] + b0[3];
                y1[0] = v[8 * j + 4] * rstd * g1[0] + b1[0]; y1[1] = v[8 * j + 5] * rstd * g1[1] + b1[1]; y1[2] = v[8 * j + 6] * rstd * g1[2] + b1[2]; y1[3] = v[8 * j + 7] * rstd * g1[3] + b1[3];
                if (fo) { *(f32x4*)(fo + c) = y0; *(f32x4*)(fo + c + 4) = y1; }
                v4u w; w.x = cvt_pk_bf16(y0[0], y0[1]); w.y = cvt_pk_bf16(y0[2], y0[3]); w.z = cvt_pk_bf16(y1[0], y1[1]); w.w = cvt_pk_bf16(y1[2], y1[3]); rp[64 * j] = w; }
        }
        __syncthreads();
        { pg8::Order S; S.init(PB, WPP_T, PB, WPP_T, PLE, PLE, M, DM, PLE, 1, G, bx, 0, 0, 0);
          pg8::EpiStore E{PBUF, DM, nullptr, 0};
          pg8::gemm_phase<pg8::EpiStore>(lds + RING_OFF, S, E); }
        if (BOTH(2)) GRID_BAR();
    }
    if (IN(3)) {
        att::prompt_units((char*)lds_raw, QB, KB, VB, SZB, YB, rel_bias, bx, G, NB * NH * 8);
        for (int it = bx; it < DECB * NH; it += G) att::sample_unit((char*)lds_raw, QB, KB, VB, SZB, YB, cache_k, cache_v, rel_bias, it >> 4, it & 15);
        for (int it = bx; it < NB * 16 * NGRP; it += G) sgu::prompt_unit(lds, GV, GU, YA, WSM, b_s, it >> 7, (it >> 3) & 15, it & 7);
        for (int it = bx; it < DECB * 4; it += (G == 256 ? 128 : G)) { if (G == 256 && bx >= 128) break; sgu::sample_unit(GV, GU, YA, w_s, b_s, it >> 2, it & 3); }
        if (BOTH(3)) GRID_BAR();
    }
    if (IN(4)) {
        { pg8::Order S; S.init(YA, WUA_T, YB, WUB_T, DBR, DBR, MP, DM, DBR, 2, G, bx, 0, 0, 0);
          pg8::EpiMerge E{SGA, SGB, MBUF};
          pg8::gemm_phase<pg8::EpiMerge>(lds + RING_OFF, S, E); }
        { pg8::Order S; S.init(YA, WUA_T, YB, WUB_T, DBR, DBR, 0, DM, DBR, 2, G, bx, MS, 8, MP / 256);
          pg8::EpiMergeSub E{SGA, SGB, SLAB, MP / 256};
          pg8::gemm_phase<pg8::EpiMergeSub>(lds + RING_OFF, S, E); }
        GRID_BAR();
        for (int i = vcu * 512 + tid; i < MS * DM / 8; i += G * 512) { f32x4 a0 = {0.f, 0.f, 0.f, 0.f}, a1 = a0;
#pragma unroll
            for (int k = 0; k < 8; ++k) { const v4u p = *(const v4u*)(SLAB + (size_t)k * (MS * DM) + (size_t)i * 8); a0 += (f32x4){bf_lo(p.x), bf_hi(p.x), bf_lo(p.y), bf_hi(p.y)}; a1 += (f32x4){bf_lo(p.z), bf_hi(p.z), bf_lo(p.w), bf_hi(p.w)}; }
            v4u w; w.x = cvt_pk_bf16(a0[0], a0[1]); w.y = cvt_pk_bf16(a0[2], a0[3]); w.z = cvt_pk_bf16(a1[0], a1[1]); w.w = cvt_pk_bf16(a1[2], a1[3]);
            *(v4u*)(MBUF + (size_t)MP * DM + (size_t)i * 8) = w; }
        if (BOTH(4)) GRID_BAR();
    }
    if (IN(5)) {
        pg8::Order S; S.init(MBUF, WOUT_T, MBUF, WOUT_T, DM, DM, MP, DM, DM, 1, G, bx, MS, 8, MP / 256); S.sub_first = bx & 1;
        pg8::EpiStore E{TB, DM, SLAB, MP / 256};
        pg8::gemm_phase<pg8::EpiStore>(lds + RING_OFF, S, E);
        if (BOTH(5)) GRID_BAR();
    }
    if (IN(6)) {
        f32x4 pg[8][2];
#pragma unroll
        for (int j = 0; j < 8; ++j) { const int c = (lane + 64 * j) * 8; pg[j][0] = *(const f32x4*)(post_g + c); pg[j][1] = *(const f32x4*)(post_g + c + 4); }
        const bool deal = (NGW == 2048); const int own_s = deal && gw < MS;
        const int r0 = deal ? (gw < MS ? gw * 5 : MS * 5 + (gw - MS) * 9) : gw, nrow = deal ? (gw < MS ? 6 : 9) : (M - gw + NGW - 1) / NGW;
        for (int j = 0; j < nrow; ++j) {
            const int m = deal ? ((own_s && j == 0) ? MP + gw : r0 + j - own_s) : gw + j * NGW;
            const float* xrow = m < MP ? x_prompt + (size_t)m * DM : x_sample + (size_t)(m - MP) * DM;
            f32x4 t0[8], t1[8], x0[8], x1[8]; float s = 0.f;
#pragma unroll
            for (int j = 0; j < 8; ++j) { const int c = (lane + 64 * j) * 8; x0[j] = *(const f32x4*)(xrow + c); x1[j] = *(const f32x4*)(xrow + c + 4); }
            if (m >= MP) {
#pragma unroll
                for (int j = 0; j < 8; ++j) { const int c = (lane + 64 * j) * 8; f32x4 a0 = {0.f, 0.f, 0.f, 0.f}, a1 = a0;
#pragma unroll
                    for (int k = 0; k < 8; ++k) { const v4u p = *(const v4u*)(SLAB + (size_t)k * (MS * DM) + (size_t)(m - MP) * DM + c); a0 += (f32x4){bf_lo(p.x), bf_hi(p.x), bf_lo(p.y), bf_hi(p.y)}; a1 += (f32x4){bf_lo(p.z), bf_hi(p.z), bf_lo(p.w), bf_hi(p.w)}; }
                    t0[j] = a0; t1[j] = a1; }
            } else {
                const v4u* tp = (const v4u*)(TB + (size_t)m * DM) + lane; v4u tw[8];
#pragma unroll
                for (int j = 0; j < 8; ++j) tw[j] = tp[64 * j];
#pragma unroll
                for (int j = 0; j < 8; ++j) { t0[j] = (f32x4){bf_lo(tw[j].x), bf_hi(tw[j].x), bf_lo(tw[j].y), bf_hi(tw[j].y)}; t1[j] = (f32x4){bf_lo(tw[j].z), bf_hi(tw[j].z), bf_lo(tw[j].w), bf_hi(tw[j].w)}; }
            }
#pragma unroll
            for (int j = 0; j < 8; ++j) { const f32x4 a0 = t0[j], a1 = t1[j]; s += (a0[0] * a0[0] + a0[1] * a0[1]) + (a0[2] * a0[2] + a0[3] * a0[3]) + (a1[0] * a1[0] + a1[1] * a1[1]) + (a1[2] * a1[2] + a1[3] * a1[3]); }
            const float r = 1.0f / sqrtf(wave_sum(s) * (1.f / DM) + EPS);
            float* yo = out + OFF_Y + (size_t)m * DM; v4u* xb = (v4u*)(X1B + (size_t)m * DM) + lane;
#pragma unroll
            for (int j = 0; j < 8; ++j) { const int c = (lane + 64 * j) * 8; const f32x4 y0 = x0[j] + t0[j] * r * pg[j][0], y1 = x1[j] + t1[j] * r * pg[j][1];
                if (m >= MP) { *(f32x4*)(yo + c) = y0; *(f32x4*)(yo + c + 4) = y1; }
                v4u w; w.x = cvt_pk_bf16(y0[0], y0[1]); w.y = cvt_pk_bf16(y0[2], y0[3]); w.z = cvt_pk_bf16(y1[0], y1[1]); w.w = cvt_pk_bf16(y1[2], y1[3]); xb[64 * j] = w; }
        }
        if (BOTH(6)) GRID_BAR();
    }
    if (IN(7)) {
        pg8::Order S; S.init(X1B, WPG_T, X1B, WPG_T, DM, DM, MP, DM, DM, 1, G, bx, MS, 8, MP / 256); S.sub_first = bx & 1;
        pg8::EpiFinal E{out + OFF_Y, PBUF, SLAB, MP / 256, X1B};
        pg8::gemm_phase<pg8::EpiFinal>(lds + RING_OFF, S, E);
        GRID_BAR();
        for (int i = vcu * 512 + tid; i < MS * DM / 4; i += G * 512) { f32x4 a = {0.f, 0.f, 0.f, 0.f};
#pragma unroll
            for (int k = 0; k < 8; ++k) { const v2u p = *(const v2u*)(SLAB + (size_t)k * (MS * DM) + (size_t)i * 4); a += (f32x4){bf_lo(p.x), bf_hi(p.x), bf_lo(p.y), bf_hi(p.y)}; }
            float* yp = out + OFF_Y + (size_t)MP * DM + (size_t)i * 4; const f32x4 x1 = *(const f32x4*)yp; const v2u p = *(const v2u*)(PBUF + (size_t)MP * DM + (size_t)i * 4);
            f32x4 y; y[0] = x1[0] + sigmoid_f(a[0]) * bf_lo(p.x); y[1] = x1[1] + sigmoid_f(a[1]) * bf_hi(p.x); y[2] = x1[2] + sigmoid_f(a[2]) * bf_lo(p.y); y[3] = x1[3] + sigmoid_f(a[3]) * bf_hi(p.y);
            *(f32x4*)yp = y; }
    }
#undef IN
#undef BOTH
#undef GRID_BAR
}

extern "C" void kernel_launch(void* const* d_in, const int* in_sizes, int n_in, void* d_out, int out_size, void* d_ws, size_t ws_size, hipStream_t stream) {
    static int grid = 0;
    if (grid == 0) {
        if (n_in != 19 || (size_t)out_size != OUT_TOTAL || ws_size < WS_END) { fprintf(stderr, "kernel_launch: unexpected shapes: n_in %d out %d ws %zu (need %zu)\n", n_in, out_size, ws_size, (size_t)WS_END); grid = -1; return; }
        int dev = 0, cus = 0, per_cu = 0;
        if (hipGetDevice(&dev) != hipSuccess || hipDeviceGetAttribute(&cus, hipDeviceAttributeMultiprocessorCount, dev) != hipSuccess) { grid = -1; return; }
        if (hipFuncSetAttribute((const void*)fwd_kernel, hipFuncAttributeMaxDynamicSharedMemorySize, LDS_BYTES) != hipSuccess) { fprintf(stderr, "kernel_launch: hipFuncSetAttribute failed\n"); grid = -1; return; }
        if (hipOccupancyMaxActiveBlocksPerMultiprocessor(&per_cu, (const void*)fwd_kernel, NWAVES * 64, LDS_BYTES) != hipSuccess || per_cu < 1)
            fprintf(stderr, "kernel_launch: note: occupancy query reports %d workgroups per CU\n", per_cu);
        (void)hipGetLastError();
        grid = cus;
    }
    if (grid < 0) return;
    if (hipMemsetAsync((char*)d_ws + WS_CTL, 0, CTL_ZERO_BYTES, stream) != hipSuccess) return;
    Args a{};
    for (int i = 0; i < 19; ++i) a.in[i] = (const float*)d_in[i];
    a.out = (float*)d_out; a.ws = (unsigned char*)d_ws;
    for (int li = 0; li < N_LAUNCHES; ++li) {
        a.ph_lo = (N_LAUNCHES == 1) ? 0 : li; a.ph_hi = (N_LAUNCHES == 1) ? N_PHASES : li + 1; a.li = li;
        hipLaunchKernelGGL(fwd_kernel, dim3(grid), dim3(NWAVES * 64), LDS_BYTES, stream, a);
        const hipError_t le = hipPeekAtLastError();
        if (le != hipSuccess) { fprintf(stderr, "kernel_launch: launch %d failed: %s\n", li, hipGetErrorName(le)); break; }
    }
}
```

```cpp
#include <hip/hip_runtime.h>
#include <cstdio>
#include <cstdint>

#ifndef MK_N_LAUNCHES
#define MK_N_LAUNCHES 1
#endif

constexpr int DM = 4096, DBR = 2048, NB = 8, SEQ = 2048, DECB = 32, DECT = 16;
constexpr int MP = NB * SEQ, MS = DECB * DECT, M = MP + MS;
constexpr int NIN = 7 * DBR + 2 * DM;
constexpr int NH = 16, HD = 128, PLE = 256, NGRP = 8, GCH = 128, GDIM = 256, CACHE = 512, NREL = 257;
constexpr float EPS = 1e-6f;
constexpr size_t OFF_Y = 0, OFF_KP = (size_t)M * DM, OFF_VP = OFF_KP + (size_t)NB * 512 * DBR, OFF_KS = OFF_VP + (size_t)NB * 512 * DBR,
                 OFF_VS = OFF_KS + (size_t)MS * DBR, OFF_GP = OFF_VS + (size_t)MS * DBR, OFF_GS = OFF_GP + (size_t)NB * GCH * DBR, OUT_TOTAL = OFF_GS + (size_t)MS * DBR;
constexpr size_t MiB = 1u << 20;
constexpr size_t WS_CTL = 0, CTL_ZERO_BYTES = 1 * MiB;
constexpr size_t WS_WIN = 1 * MiB, WS_WUA = 177 * MiB, WS_WUB = 193 * MiB, WS_WOUT = 209 * MiB, WS_WPG = 241 * MiB, WS_WPP = 273 * MiB, WS_WS = 275 * MiB, WS_PB = 276 * MiB;
constexpr size_t WS_H = 285 * MiB;
constexpr size_t WS_SEG = 417 * MiB;
constexpr size_t SEG2K = (size_t)M * DBR * 2;
constexpr size_t WS_P = 1143 * MiB, WS_SLAB = 1275 * MiB, WS_END = 1339 * MiB;
constexpr size_t WS_MBUF = WS_SEG, WS_T = WS_SEG + 2 * SEG2K, WS_X1B = WS_SEG + 4 * SEG2K;
static_assert(SEG2K == 66 * MiB && WS_SEG + 7 * SEG2K + 4 * SEG2K == WS_P && WS_H + 2 * SEG2K == WS_SEG, "ws map");
constexpr int CW_TMO = 0, CW_BAR = 4096;

#define GAS __attribute__((address_space(1)))
#define LAS __attribute__((address_space(3)))
typedef unsigned short bf16;
typedef unsigned v4u __attribute__((ext_vector_type(4)));
typedef unsigned v2u __attribute__((ext_vector_type(2)));
typedef float f32x4 __attribute__((ext_vector_type(4)));
typedef float f32x2 __attribute__((ext_vector_type(2)));
typedef float f32x16 __attribute__((ext_vector_type(16)));
typedef short bf16x8 __attribute__((ext_vector_type(8)));
typedef short s16x4 __attribute__((ext_vector_type(4)));
typedef GAS unsigned gu32;
#define RLX_AGENT __ATOMIC_RELAXED, __HIP_MEMORY_SCOPE_AGENT
#define LDS_WAIT() asm volatile("s_waitcnt lgkmcnt(0)" ::: "memory")
#define VM_WAIT() asm volatile("s_waitcnt vmcnt(0)" ::: "memory")

typedef __bf16 bf16x2_t __attribute__((ext_vector_type(2)));
__device__ __forceinline__ unsigned cvt_pk_bf16(float lo, float hi) { const f32x2 v = {lo, hi}; return __builtin_bit_cast(unsigned, __builtin_convertvector(v, bf16x2_t)); }
__device__ __forceinline__ float bf_lo(unsigned w) { return __uint_as_float(w << 16); }
__device__ __forceinline__ float bf_hi(unsigned w) { return __uint_as_float(w & 0xffff0000u); }
__device__ __forceinline__ float bf2f(bf16 b) { return __uint_as_float(((unsigned)b) << 16); }
__device__ __forceinline__ float sigmoid_f(float v) { return __builtin_amdgcn_rcpf(1.0f + __builtin_amdgcn_exp2f(-1.4426950408889634f * v)); }
__device__ __forceinline__ float silu_f(float v) { return v * sigmoid_f(v); }
__device__ __forceinline__ f32x2 gelu_pk(f32x2 v) {
    const f32x2 av = __builtin_elementwise_abs(v), d = av * 0.2316418882f + 1.0f;
    f32x2 t; t.x = __builtin_amdgcn_rcpf(d.x); t.y = __builtin_amdgcn_rcpf(d.y);
    f32x2 q = t * 0.5307027145f + (-0.7265760135f); q = q * t + 0.7107068705f; q = q * t + (-0.142248368f); q = q * t + 0.127414796f; q = q * t;
    const f32x2 s = (v * v) * (-0.72134752044f);
    f32x2 e; e.x = __builtin_amdgcn_exp2f(s.x); e.y = __builtin_amdgcn_exp2f(s.y);
    const f32x2 m = v * (q * e), r = v - m;
    f32x2 o; o.x = v.x < 0.f ? m.x : r.x; o.y = v.y < 0.f ? m.y : r.y; return o;
}
__device__ __forceinline__ float wave_sum(float v) {
#pragma unroll
    for (int o = 1; o < 64; o <<= 1) v += __shfl_xor(v, o);
    return v;
}

namespace pg8 {
#define PG8_LAS __attribute__((address_space(3)))
typedef unsigned short bf16_t;
constexpr int BM = 256, BK = 64, HALF = 128, HTB = HALF * BK * 2, STAGE_BYTES = 8 * HTB, NXCD = 8, WGM = 8;
__host__ __device__ __forceinline__ int lds_byte(int r, int c) { const int st = (r >> 4) * 2 + (c >> 5), rr = r & 15, cc = c & 31, ob = rr * 64 + cc * 2; return st * 1024 + (ob ^ (((ob >> 9) & 1) << 5)); }
__host__ __device__ __forceinline__ void stage_rc(int b, int& R, int& C) { const int st = b / 1024, sb = b % 1024, swz = sb ^ (((sb >> 9) & 1) << 5); R = (st >> 1) * 16 + swz / 64; C = (st & 1) * 32 + (swz % 64) / 2; }
__host__ __device__ __forceinline__ int perm32(int rho) { const int n = rho >> 4, i = rho & 15; return 8 * (i >> 2) + 4 * n + (i & 3); }

struct Unit { int pm, pn, seg, kind, ks, nt; const char* a; const char* b; };
struct Order {
    const bf16_t *A, *Bt, *A2, *Bt2; int lda, ldb;
    int nMf, nN, nfull, G, c, nseg, ntf, nsub, nslice, nts, pm_sub0, nf_c, sub_first = 0, w0 = 0;
    __device__ void init(const bf16_t* A_, const bf16_t* Bt_, const bf16_t* A2_, const bf16_t* Bt2_, int lda_, int ldb_, int Mfull, int N_, int Kseg, int nseg_, int G_, int c_, int Msub, int nslice_, int pm_sub0_) {
        A = A_; Bt = Bt_; A2 = A2_; Bt2 = Bt2_; lda = lda_; ldb = ldb_; nMf = Mfull / BM; nN = N_ / BM; nfull = nMf * nN; G = G_; c = c_; nseg = nseg_; ntf = Kseg / BK;
        nslice = nslice_; nsub = (Msub / BM) * nN * nslice_; nts = nslice_ ? (Kseg * nseg_ / nslice_) / BK : 0; pm_sub0 = pm_sub0_;
        nf_c = (c < nfull) ? (nfull - c + G - 1) / G : 0;
    }
    __device__ void set_range(int w0_, int w1_) { w0 = w0_; const int cnt = w1_ - w0_; nf_c = (c >= 0 && c < cnt) ? (cnt - c + G - 1) / G : 0; }
    __device__ bool next(int i_, Unit& u) const {
        int i = i_; const size_t tA = (size_t)BM * lda * 2, tB = (size_t)BM * ldb * 2;
        const int ns_c = (c < nsub) ? (nsub - c + G - 1) / G : 0;
        if (sub_first) { if (i_ < ns_c) i = nf_c * nseg + i_; else { i = i_ - ns_c; if (i >= nf_c * nseg) return false; } }
        if (i < nf_c * nseg) {
            const int r = (nseg == 2) ? (i >> 1) : i; u.seg = (nseg == 2) ? (i & 1) : 0; u.kind = 0; u.ks = 0; u.nt = ntf;
            int wgid = w0 + r * G + c; { const int q = nfull / NXCD, rr = nfull % NXCD, xcd = wgid % NXCD, off = wgid / NXCD; wgid = (xcd < rr ? xcd * (q + 1) : rr * (q + 1) + (xcd - rr) * q) + off; }
            const int nig = WGM * nN, gid = wgid / nig, fm = gid * WGM, gsz = (nMf - fm) < WGM ? (nMf - fm) : WGM;
            u.pm = fm + ((wgid % nig) % gsz); u.pn = (wgid % nig) / gsz;
            u.a = (const char*)(u.seg ? A2 : A) + (size_t)u.pm * tA; u.b = (const char*)(u.seg ? Bt2 : Bt) + (size_t)u.pn * tB; return true;
        }
        const long sidx = (long)(nf_c + (i - nf_c * nseg)) * G + c - nfull;
        if (sidx < 0 || sidx >= nsub) return false;
        const int s = (int)sidx, ks = s % nslice, tile = s / nslice, sps = nslice / nseg;
        u.kind = 1; u.ks = ks; u.nt = nts; u.pn = tile % nN; u.pm = pm_sub0 + tile / nN; u.seg = ks / sps;
        const size_t kofs = (size_t)(ks % sps) * nts * BK * 2;
        u.a = (const char*)(u.seg ? A2 : A) + (size_t)u.pm * tA + kofs; u.b = (const char*)(u.seg ? Bt2 : Bt) + (size_t)u.pn * tB + kofs; return true;
    }
};

template <class Epi, bool ALIGN_EPI = true>
__device__ __forceinline__ void gemm_phase(PG8_LAS unsigned char* lds, const Order& S, const Epi& E) {
    const int tid = threadIdx.x, wid = __builtin_amdgcn_readfirstlane(tid >> 6), lane = tid & 63, wr = wid >> 2, wc = wid & 3, fr = lane & 15, fq = lane >> 4;
    unsigned voffA[2], voffB[2];
#pragma unroll
    for (int i = 0; i < 2; ++i) { int R, C; stage_rc(tid * 16 + i * 8192, R, C); const int Rb = Epi::PERM ? ((R & ~31) + perm32(R & 31)) : R;
        voffA[i] = (unsigned)(R * S.lda + C) * 2u; voffB[i] = (unsigned)(Rb * S.ldb + C) * 2u; }
    const size_t kstep = (size_t)(BK * 2);
    const size_t hstepA = (size_t)HALF * S.lda * 2, hstepB = (size_t)HALF * S.ldb * 2;
    const unsigned ldsw = (unsigned)wid * 1024u;
    const int aoff = lds_byte(wr * 64 + fr, fq * 8), boff = lds_byte(wc * 32 + fr, fq * 8);
#define PG8_SA(b, h) (((b) * 2 + (h)) * HTB)
#define PG8_SB(b, h) ((4 + (b) * 2 + (h)) * HTB)
#define PG8_STAGE(bufoff, gbase, voff) do { _Pragma("unroll") for (int _i = 0; _i < 2; ++_i) \
        __builtin_amdgcn_global_load_lds((const unsigned*)((const char*)(gbase) + (voff)[_i]), (PG8_LAS unsigned*)(lds + (bufoff) + ldsw + _i * 8192), 16, 0, 0); } while (0)
#define PG8_LDA(dst, b, h) do { _Pragma("unroll") for (int m = 0; m < 4; ++m) _Pragma("unroll") for (int k = 0; k < 2; ++k) dst[m][k] = *(const PG8_LAS bf16x8*)(lds + PG8_SA(b, h) + aoff + m * 2048 + k * 1024); } while (0)
#define PG8_LDB(dst, b, h) do { _Pragma("unroll") for (int n = 0; n < 2; ++n) _Pragma("unroll") for (int k = 0; k < 2; ++k) dst[n][k] = *(const PG8_LAS bf16x8*)(lds + PG8_SB(b, h) + boff + n * 2048 + k * 1024); } while (0)
#define PG8_MMA(ai, bj, At, Bt) do { __builtin_amdgcn_sched_barrier(0); __builtin_amdgcn_s_setprio(1); _Pragma("unroll") for (int m = 0; m < 4; ++m) _Pragma("unroll") for (int n = 0; n < 2; ++n) _Pragma("unroll") for (int k = 0; k < 2; ++k) \
        acc[ai][bj][m][n] = __builtin_amdgcn_mfma_f32_16x16x32_bf16(Bt[n][k], At[m][k], acc[ai][bj][m][n], 0, 0, 0); __builtin_amdgcn_s_setprio(0); __builtin_amdgcn_sched_barrier(0); } while (0)
#define PG8_WAIT_V(n) asm volatile("s_waitcnt vmcnt(" #n ")" ::: "memory")
#define PG8_WAIT_L(n) asm volatile("s_waitcnt lgkmcnt(" #n ")" ::: "memory")
#define PG8_BAR __builtin_amdgcn_s_barrier()
#define PG8_SCHED __builtin_amdgcn_sched_barrier(0)
    Unit cur, nxt; int ui = 0;
    if (!S.next(0, cur)) return;
    f32x4 acc[2][2][4][2];
#pragma unroll
    for (int a = 0; a < 2; ++a)
#pragma unroll
        for (int b = 0; b < 2; ++b)
#pragma unroll
            for (int m = 0; m < 4; ++m)
#pragma unroll
                for (int n = 0; n < 2; ++n) acc[a][b][m][n] = (f32x4){0.f, 0.f, 0.f, 0.f};
    bf16x8 At[4][2], B0[2][2], B1[2][2];
    const char* cA = cur.a; const char* cB = cur.b;
    PG8_STAGE(PG8_SB(0, 0), cB, voffB); PG8_STAGE(PG8_SB(0, 1), cB + hstepB, voffB); PG8_STAGE(PG8_SA(0, 0), cA, voffA); PG8_STAGE(PG8_SA(0, 1), cA + hstepA, voffA);
    if (wr == 1) PG8_BAR;
    PG8_WAIT_V(2); PG8_BAR;
    PG8_STAGE(PG8_SB(1, 0), cB + kstep, voffB); PG8_STAGE(PG8_SA(1, 0), cA + kstep, voffA); PG8_STAGE(PG8_SB(1, 1), cB + hstepB + kstep, voffB);
    PG8_WAIT_V(6); PG8_BAR;
    for (;;) {
        const bool has_next = S.next(ui + 1, nxt);
        const char* nA = has_next ? nxt.a : cA; const char* nB = has_next ? nxt.b : cB;
        const int nt = cur.nt;
        for (int t = 0; t < nt; t += 2) {
            const bool last = (t == nt - 2);
            const char* a1 = cA + (size_t)(t + 1) * kstep;
            const char* a2 = last ? nA : cA + (size_t)(t + 2) * kstep; const char* b2 = last ? nB : cB + (size_t)(t + 2) * kstep;
            const char* a3 = a2 + kstep; const char* b3 = b2 + kstep;
            PG8_LDB(B0, 0, 0); PG8_LDB(B1, 0, 1); PG8_SCHED; PG8_LDA(At, 0, 0); PG8_STAGE(PG8_SA(1, 1), a1 + hstepA, voffA);
            PG8_WAIT_V(8); PG8_WAIT_L(0); PG8_BAR; PG8_MMA(0, 0, At, B0); PG8_MMA(0, 1, At, B1); PG8_BAR; PG8_SCHED;
            PG8_LDA(At, 0, 1); PG8_STAGE(PG8_SB(0, 0), b2, voffB); PG8_STAGE(PG8_SB(0, 1), b2 + hstepB, voffB); PG8_STAGE(PG8_SA(0, 0), a2, voffA);
            PG8_WAIT_V(8); PG8_WAIT_L(0); PG8_BAR; PG8_MMA(1, 0, At, B0); PG8_MMA(1, 1, At, B1); PG8_BAR; PG8_SCHED;
            PG8_LDB(B0, 1, 0); PG8_LDB(B1, 1, 1); PG8_SCHED; PG8_LDA(At, 1, 0); PG8_STAGE(PG8_SA(0, 1), a2 + hstepA, voffA);
            PG8_WAIT_V(8); PG8_WAIT_L(0); PG8_BAR; PG8_MMA(0, 0, At, B0); PG8_MMA(0, 1, At, B1); PG8_BAR; PG8_SCHED;
            PG8_LDA(At, 1, 1); PG8_STAGE(PG8_SB(1, 0), b3, voffB); PG8_STAGE(PG8_SB(1, 1), b3 + hstepB, voffB); PG8_STAGE(PG8_SA(1, 0), a3, voffA);
            PG8_WAIT_V(8); PG8_WAIT_L(0); PG8_BAR; PG8_MMA(1, 0, At, B0); PG8_MMA(1, 1, At, B1); PG8_BAR; PG8_SCHED;
        }
        if (ALIGN_EPI) { if (wr == 0) PG8_BAR; }
        E(acc, cur, wr, wc, fr, fq);
        if (!has_next) break;
        if (!(Epi::TWOSEG && nxt.seg == 1)) {
#pragma unroll
        for (int a = 0; a < 2; ++a)
#pragma unroll
            for (int b = 0; b < 2; ++b)
#pragma unroll
                for (int m = 0; m < 4; ++m)
#pragma unroll
                    for (int n = 0; n < 2; ++n) acc[a][b][m][n] = (f32x4){0.f, 0.f, 0.f, 0.f};
        }
        cur = nxt; cA = nA; cB = nB; ++ui;
        if (ALIGN_EPI) { if (wr == 1) PG8_BAR; }
    }
    PG8_WAIT_V(0);
    if (!ALIGN_EPI) { if (wr == 0) PG8_BAR; }
    PG8_BAR;
#undef PG8_SA
#undef PG8_SB
#undef PG8_STAGE
#undef PG8_LDA
#undef PG8_LDB
#undef PG8_MMA
#undef PG8_WAIT_V
#undef PG8_WAIT_L
#undef PG8_BAR
#undef PG8_SCHED
}

template <bool PERM_>
__device__ __forceinline__ void slab_store(const f32x4 (&acc)[2][2][4][2], const Unit& u, int wr, int wc, int fr, int fq, bf16_t* slab, int pm_sub0, const bf16_t* Gt, const bf16_t* Gt2 = nullptr) {
    const int rloc = (u.pm - pm_sub0) * BM + wr * 64 + fr, grow = u.pm * BM + wr * 64 + fr;
    bf16_t* sb = slab + (size_t)u.ks * (512 * DM);
#pragma unroll
    for (int ai = 0; ai < 2; ++ai)
#pragma unroll
        for (int m = 0; m < 4; ++m) {
#pragma unroll
            for (int bj = 0; bj < 2; ++bj) {
                if (PERM_) { const int col = u.pn * BM + bj * HALF + wc * 32 + 8 * fq; f32x4 v0 = acc[ai][bj][m][0], v1 = acc[ai][bj][m][1];
                    if (Gt) { const v4u b = *(const v4u*)(Gt + (size_t)(grow + ai * HALF + m * 16) * DM + col); v0 *= (f32x4){bf_lo(b.x), bf_hi(b.x), bf_lo(b.y), bf_hi(b.y)}; v1 *= (f32x4){bf_lo(b.z), bf_hi(b.z), bf_lo(b.w), bf_hi(b.w)}; }
                    if (Gt2) { const v4u b = *(const v4u*)(Gt2 + (size_t)(grow + ai * HALF + m * 16) * DM + col); v0 *= (f32x4){bf_lo(b.x), bf_hi(b.x), bf_lo(b.y), bf_hi(b.y)}; v1 *= (f32x4){bf_lo(b.z), bf_hi(b.z), bf_lo(b.w), bf_hi(b.w)}; }
                    v4u w; w.x = cvt_pk_bf16(v0[0], v0[1]); w.y = cvt_pk_bf16(v0[2], v0[3]); w.z = cvt_pk_bf16(v1[0], v1[1]); w.w = cvt_pk_bf16(v1[2], v1[3]);
                    *(v4u*)(sb + (size_t)(rloc + ai * HALF + m * 16) * DM + col) = w; }
                else {
#pragma unroll
                    for (int n = 0; n < 2; ++n) { const int col = u.pn * BM + bj * HALF + wc * 32 + 16 * n + 4 * fq; const f32x4 v = acc[ai][bj][m][n];
                        v2u w; w.x = cvt_pk_bf16(v[0], v[1]); w.y = cvt_pk_bf16(v[2], v[3]); *(v2u*)(sb + (size_t)(rloc + ai * HALF + m * 16) * DM + col) = w; } }
            }
            asm volatile("" ::: "memory"); }
}
struct EpiStore {
    static constexpr bool PERM = true, TWOSEG = false;
    bf16_t* O; int ldc; bf16_t* slab; int pm_sub0;
    __device__ __forceinline__ void operator()(f32x4 (&acc)[2][2][4][2], const Unit& u, int wr, int wc, int fr, int fq) const {
        if (u.kind == 1) { slab_store<true>(acc, u, wr, wc, fr, fq, slab, pm_sub0, nullptr); return; }
        const int row0 = u.pm * BM + wr * 64 + fr, col0 = u.pn * BM + wc * 32 + 8 * fq;
#pragma unroll
        for (int ai = 0; ai < 2; ++ai)
#pragma unroll
            for (int m = 0; m < 4; ++m) { bf16_t* rowp = O + (size_t)(row0 + ai * HALF + m * 16) * ldc + col0;
#pragma unroll
                for (int bj = 0; bj < 2; ++bj) { const f32x4 v0 = acc[ai][bj][m][0], v1 = acc[ai][bj][m][1];
                    v4u w; w.x = cvt_pk_bf16(v0[0], v0[1]); w.y = cvt_pk_bf16(v0[2], v0[3]); w.z = cvt_pk_bf16(v1[0], v1[1]); w.w = cvt_pk_bf16(v1[2], v1[3]);
                    *(v4u*)(rowp + bj * HALF) = w; } }
    }
};
struct EpiIn {
    static constexpr bool PERM = true, TWOSEG = false;
    bf16_t* seg0; float* out; int pmo;
    template <int ACT, bool F32OUT>
    __device__ __forceinline__ void run(const f32x4 (&acc)[2][2][4][2], bf16_t* O, int ldc, int row0, int col0, float* fo) const {
#pragma unroll
        for (int ai = 0; ai < 2; ++ai)
#pragma unroll
            for (int m = 0; m < 4; ++m) { bf16_t* rowp = O + (size_t)(row0 + ai * HALF + m * 16) * ldc + col0;
#pragma unroll
                for (int bj = 0; bj < 2; ++bj) { f32x4 v0 = acc[ai][bj][m][0], v1 = acc[ai][bj][m][1];
                    if (F32OUT) { float* fp = fo + (size_t)(ai * HALF + m * 16) * DBR + bj * HALF; *(f32x4*)fp = v0; *(f32x4*)(fp + 4) = v1; }
                    if (ACT == 1) { f32x2 a = gelu_pk((f32x2){v0[0], v0[1]}), b = gelu_pk((f32x2){v0[2], v0[3]}), c = gelu_pk((f32x2){v1[0], v1[1]}), d = gelu_pk((f32x2){v1[2], v1[3]});
                        v0 = (f32x4){a.x, a.y, b.x, b.y}; v1 = (f32x4){c.x, c.y, d.x, d.y}; }
                    if (ACT == 2) {
#pragma unroll
                        for (int j = 0; j < 4; ++j) { v0[j] = silu_f(v0[j]); v1[j] = silu_f(v1[j]); } }
                    if (ACT == 3) {
#pragma unroll
                        for (int j = 0; j < 4; ++j) { v0[j] = sigmoid_f(v0[j]); v1[j] = sigmoid_f(v1[j]); } }
                    v4u w; w.x = cvt_pk_bf16(v0[0], v0[1]); w.y = cvt_pk_bf16(v0[2], v0[3]); w.z = cvt_pk_bf16(v1[0], v1[1]); w.w = cvt_pk_bf16(v1[2], v1[3]);
                    *(v4u*)(rowp + bj * HALF) = w; } }
    }
    template <int KIND  >
    __device__ __forceinline__ void run_pair(const f32x4 (&acc)[2][2][4][2], bf16_t* O1, bf16_t* O2, int ldc, int row0, int ch0) const {
#pragma unroll
        for (int ai = 0; ai < 2; ++ai)
#pragma unroll
            for (int m = 0; m < 4; ++m) { const size_t ro = (size_t)(row0 + ai * HALF + m * 16) * ldc + ch0;
#pragma unroll
                for (int bj = 0; bj < 2; ++bj) { const f32x4 v0 = acc[ai][bj][m][0], v1 = acc[ai][bj][m][1];
                    if (KIND == 0) { const f32x2 a = gelu_pk((f32x2){v0[0], v0[1]}), b = gelu_pk((f32x2){v0[2], v0[3]});
                        v2u w; w.x = cvt_pk_bf16(a.x * silu_f(v1[0]), a.y * silu_f(v1[1])); w.y = cvt_pk_bf16(b.x * silu_f(v1[2]), b.y * silu_f(v1[3]));
                        *(v2u*)(O1 + ro + bj * (HALF / 2)) = w; }
                    else { float r[4], sb[4];
#pragma unroll
                        for (int j = 0; j < 4; ++j) { const float ea = __builtin_amdgcn_exp2f(-1.4426950408889634f * v0[j]), eb = __builtin_amdgcn_exp2f(-1.4426950408889634f * v1[j]);
                            sb[j] = __builtin_amdgcn_rcpf(1.0f + eb); r[j] = (1.0f + eb) * __builtin_amdgcn_rcpf(1.0f + ea); }
                        v2u w1, w2; w1.x = cvt_pk_bf16(r[0], r[1]); w1.y = cvt_pk_bf16(r[2], r[3]); w2.x = cvt_pk_bf16(sb[0], sb[1]); w2.y = cvt_pk_bf16(sb[2], sb[3]);
                        *(v2u*)(O1 + ro + bj * (HALF / 2)) = w1; *(v2u*)(O2 + ro + bj * (HALF / 2)) = w2; } } }
    }
    __device__ __forceinline__ void operator()(f32x4 (&acc)[2][2][4][2], const Unit& u, int wr, int wc, int fr, int fq) const {
        const int pn = u.pn, pm = u.pm + pmo, rloc = wr * 64 + fr, row0 = pm * BM + rloc;
        if (pn >= 56) { const int ch0 = (pn - 56) * HALF + wc * 16 + 4 * fq;
            run_pair<1>(acc, seg0 + (size_t)7 * M * DBR, seg0 + (size_t)7 * M * DBR + (size_t)M * DM, DM, row0, ch0); return; }
        if (pn < 16) { run_pair<0>(acc, seg0, nullptr, DBR, row0, pn * HALF + wc * 16 + 4 * fq); return; }
        if (pn < 24) { run<1, false>(acc, seg0 + (size_t)M * DBR, DBR, row0, (pn - 16) * BM + wc * 32 + 8 * fq, nullptr); return; }
        const int s = pn >> 3, col0 = (pn & 7) * BM + wc * 32 + 8 * fq; bf16_t* O = seg0 + (size_t)s * M * DBR;
        if (s == 6) { run<2, false>(acc, O, DBR, row0, col0, nullptr); return; }
        if (s == 3) { run<0, false>(acc, O, DBR, row0, col0, nullptr); return; }
        float* fo = nullptr;
        if (pm >= 64) fo = out + (s == 4 ? OFF_KS : OFF_VS) + (size_t)((pm - 64) * BM + rloc) * DBR + col0;
        else if ((pm & 7) >= 6) fo = out + (s == 4 ? OFF_KP : OFF_VP) + (size_t)((pm >> 3) * 512 + ((pm & 7) - 6) * BM + rloc) * DBR + col0;
        if (fo) run<0, true>(acc, O, DBR, row0, col0, fo); else run<0, false>(acc, O, DBR, row0, col0, nullptr);
    }
};
struct EpiMerge {
    static constexpr bool PERM = true, TWOSEG = true;
    const bf16_t* SGA; const bf16_t* SGB; bf16_t* O;
    __device__ __forceinline__ void operator()(f32x4 (&acc)[2][2][4][2], const Unit& u, int wr, int wc, int fr, int fq) const {
        const int row0 = u.pm * BM + wr * 64 + fr, col0 = u.pn * BM + wc * 32 + 8 * fq;
#define MG_OFF(it) ((size_t)(row0 + ((it) >> 2) * HALF + ((it) & 3) * 16) * DM + col0)
        if (u.seg == 0) {
            v4u ga[2][2];
            { const size_t off = MG_OFF(0); ga[0][0] = *(const v4u*)(SGA + off); ga[0][1] = *(const v4u*)(SGA + off + HALF); }
#pragma unroll
            for (int it = 0; it < 8; ++it) { const int ai = it >> 2, m = it & 3, cb = it & 1, nb = cb ^ 1;
                if (it + 1 < 8) { const size_t off = MG_OFF(it + 1); ga[nb][0] = *(const v4u*)(SGA + off); ga[nb][1] = *(const v4u*)(SGA + off + HALF); }
                asm volatile("" ::: "memory");
#pragma unroll
                for (int bj = 0; bj < 2; ++bj) { const v4u a = ga[cb][bj];
                    acc[ai][bj][m][0] *= (f32x4){bf_lo(a.x), bf_hi(a.x), bf_lo(a.y), bf_hi(a.y)}; acc[ai][bj][m][1] *= (f32x4){bf_lo(a.z), bf_hi(a.z), bf_lo(a.w), bf_hi(a.w)}; }
                asm volatile("" ::: "memory"); }
        } else {
            v4u gb[2][2];
            { const size_t off = MG_OFF(0); gb[0][0] = *(const v4u*)(SGB + off); gb[0][1] = *(const v4u*)(SGB + off + HALF); }
#pragma unroll
            for (int it = 0; it < 8; ++it) { const int ai = it >> 2, m = it & 3, cb = it & 1, nb = cb ^ 1;
                if (it + 1 < 8) { const size_t off = MG_OFF(it + 1); gb[nb][0] = *(const v4u*)(SGB + off); gb[nb][1] = *(const v4u*)(SGB + off + HALF); }
                asm volatile("" ::: "memory");
                const size_t off = MG_OFF(it);
#pragma unroll
                for (int bj = 0; bj < 2; ++bj) { const v4u b = gb[cb][bj];
                    const f32x4 v0 = acc[ai][bj][m][0] * (f32x4){bf_lo(b.x), bf_hi(b.x), bf_lo(b.y), bf_hi(b.y)}, v1 = acc[ai][bj][m][1] * (f32x4){bf_lo(b.z), bf_hi(b.z), bf_lo(b.w), bf_hi(b.w)};
                    v4u w; w.x = cvt_pk_bf16(v0[0], v0[1]); w.y = cvt_pk_bf16(v0[2], v0[3]); w.z = cvt_pk_bf16(v1[0], v1[1]); w.w = cvt_pk_bf16(v1[2], v1[3]);
                    *(v4u*)(O + off + bj * HALF) = w; }
                asm volatile("" ::: "memory"); }
        }
#undef MG_OFF
    }
};
struct EpiMergeSub {
    static constexpr bool PERM = true, TWOSEG = false;
    const bf16_t* SGA; const bf16_t* SGB; bf16_t* slab; int pm_sub0;
    __device__ __forceinline__ void operator()(f32x4 (&acc)[2][2][4][2], const Unit& u, int wr, int wc, int fr, int fq) const {
        slab_store<true>(acc, u, wr, wc, fr, fq, slab, pm_sub0, SGB, u.seg ? nullptr : SGA);
    }
};
struct EpiFinal {
    static constexpr bool PERM = false, TWOSEG = false;
    float* Y; const bf16_t* P; bf16_t* slab; int pm_sub0; const bf16_t* XB;
    __device__ __forceinline__ void operator()(f32x4 (&acc)[2][2][4][2], const Unit& u, int wr, int wc, int fr, int fq) const {
        if (u.kind == 1) { slab_store<false>(acc, u, wr, wc, fr, fq, slab, pm_sub0, nullptr); return; }
        const int row0 = u.pm * BM + wr * 64 + fr, col0 = u.pn * BM + wc * 32 + 4 * fq;
#define FN_OFF(it) ((size_t)(row0 + ((it) >> 2) * HALF + ((it) & 3) * 16) * DM + col0)
        v2u xv[2][4], pv[2][4];
        { const size_t off = FN_OFF(0);
#pragma unroll
          for (int q = 0; q < 4; ++q) { const size_t o2 = off + (q >> 1) * HALF + (q & 1) * 16; xv[0][q] = *(const v2u*)(XB + o2); pv[0][q] = *(const v2u*)(P + o2); } }
#pragma unroll
        for (int it = 0; it < 8; ++it) { const int ai = it >> 2, m = it & 3, cb = it & 1, nb = cb ^ 1;
            if (it + 1 < 8) { const size_t off = FN_OFF(it + 1);
#pragma unroll
                for (int q = 0; q < 4; ++q) { const size_t o2 = off + (q >> 1) * HALF + (q & 1) * 16; xv[nb][q] = *(const v2u*)(XB + o2); pv[nb][q] = *(const v2u*)(P + o2); } }
            asm volatile("" ::: "memory");
            const size_t off = FN_OFF(it);
#pragma unroll
            for (int q = 0; q < 4; ++q) { const int bj = q >> 1, n = q & 1; const size_t o2 = off + bj * HALF + n * 16; const v2u x1 = xv[cb][q], p = pv[cb][q]; const f32x4 a = acc[ai][bj][m][n];
                f32x4 y; y[0] = bf_lo(x1.x) + sigmoid_f(a[0]) * bf_lo(p.x); y[1] = bf_hi(x1.x) + sigmoid_f(a[1]) * bf_hi(p.x); y[2] = bf_lo(x1.y) + sigmoid_f(a[2]) * bf_lo(p.y); y[3] = bf_hi(x1.y) + sigmoid_f(a[3]) * bf_hi(p.y);
                *(f32x4*)(Y + o2) = y; }
            asm volatile("" ::: "memory"); }
#undef FN_OFF
    }
};
}

namespace att {
constexpr float SCALE = 0.08838834764831845f, THR = 8.f;
constexpr int SHM = 16384;
constexpr int OFF_V = 0, OFF_K = 2 * SHM, OFF_TAB = 4 * SHM, OFF_WS = 4 * SHM + 2048, LDS_NEED = OFF_WS + 8 * 256;
#define KSWZ(row, colB) ((row) * 256 + ((colB) ^ (((row) & 7) << 4)))
#define SBAR() __builtin_amdgcn_sched_barrier(0)
__device__ __forceinline__ int v_st(int k, int c) { const int kk = (k & ~0xC) | ((k & 4) << 1) | ((k & 8) >> 1); return ((kk >> 3) * 4 + (c >> 5)) * 512 + ((kk & 7) * 32 + (c & 31)) * 2; }
__device__ __forceinline__ int v_rd_base(int lane) { return ((lane & 3) << 3) | (((lane >> 2) & 3) << 6) | (((lane >> 4) & 1) << 5) | (((lane >> 5) & 1) << 8); }
constexpr int v_rd_off(int d0, int ks, int half) { return d0 * 512 + ks * 4096 + half * 2048; }
__device__ __forceinline__ int crow(int r, int hi) { return (r & 3) + 8 * (r >> 2) + 4 * hi; }
__device__ __forceinline__ void partialSM(f32x16& p0, f32x16& p1, float& m_reg, float& mn, float& alpha) {
    float pmax = p0[0];
#pragma unroll
    for (int r = 1; r < 16; ++r) pmax = fmaxf(pmax, p0[r]);
#pragma unroll
    for (int r = 0; r < 16; ++r) pmax = fmaxf(pmax, p1[r]);
    { auto rr = __builtin_amdgcn_permlane32_swap(__float_as_uint(pmax), __float_as_uint(pmax), false, false);
      pmax = fmaxf(__uint_as_float(rr[0]), __uint_as_float(rr[1])); }
    constexpr float C2 = 1.4426950408889634f * SCALE;
    if (__builtin_expect(__all((pmax - m_reg) * SCALE <= THR), 1)) { mn = m_reg; alpha = 1.f; }
    else { mn = fmaxf(m_reg, pmax); alpha = __builtin_amdgcn_exp2f((m_reg - mn) * C2); m_reg = mn; }
    const float mnL = -mn * C2;
#pragma unroll
    for (int r = 0; r < 16; ++r) p0[r] = fmaf(p0[r], C2, mnL);
#pragma unroll
    for (int r = 0; r < 16; ++r) p1[r] = fmaf(p1[r], C2, mnL);
#pragma unroll
    for (int r = 0; r < 16; ++r) p0[r] = __builtin_amdgcn_exp2f(p0[r]);
}
__device__ __forceinline__ void finishSM(f32x16& p0, f32x16& p1, float alpha, float& l_reg, bf16x8& pa0, bf16x8& pa1, bf16x8& pa2, bf16x8& pa3) {
#pragma unroll
    for (int r = 0; r < 16; ++r) p1[r] = __builtin_amdgcn_exp2f(p1[r]);
    float ps = 0;
#pragma unroll
    for (int r = 0; r < 16; ++r) ps += p0[r];
#pragma unroll
    for (int r = 0; r < 16; ++r) ps += p1[r];
    { auto rr = __builtin_amdgcn_permlane32_swap(__float_as_uint(ps), __float_as_uint(ps), false, false);
      ps = __uint_as_float(rr[0]) + __uint_as_float(rr[1]); }
    l_reg = l_reg * alpha + ps;
#define PK4(P, B_, OUT) do { unsigned a0 = cvt_pk_bf16(P[B_+0], P[B_+1]), a1 = cvt_pk_bf16(P[B_+2], P[B_+3]);                          \
        unsigned b0 = cvt_pk_bf16(P[B_+4], P[B_+5]), b1 = cvt_pk_bf16(P[B_+6], P[B_+7]);                                             \
        auto r0 = __builtin_amdgcn_permlane32_swap(a0, b0, false, false); auto r1 = __builtin_amdgcn_permlane32_swap(a1, b1, false, false); \
        v4u w = {r0[0], r1[0], r0[1], r1[1]}; OUT = *reinterpret_cast<bf16x8*>(&w); } while (0)
    PK4(p0, 0, pa0); PK4(p0, 8, pa1); PK4(p1, 0, pa2); PK4(p1, 8, pa3);
#undef PK4
}
template <int KB>
__device__ __forceinline__ void qkt(f32x16& p0, f32x16& p1, const char* K_lds, int r32, int hi, const bf16x8* qr) {
    const char* kb[4];
#pragma unroll
    for (int dd = 0; dd < 4; ++dd) kb[dd] = K_lds + KB * SHM + KSWZ(r32, (dd * 16 + hi * 8) * 2);
#pragma unroll
    for (int hf = 0; hf < 2; ++hf) {
        bf16x8 f0[4], f1[4];
#pragma unroll
        for (int dd = 0; dd < 4; ++dd) { const char* a = kb[dd] + hf * 128; f0[dd] = *reinterpret_cast<const bf16x8*>(a); f1[dd] = *reinterpret_cast<const bf16x8*>(a + 32 * 256); }
        asm volatile("s_waitcnt lgkmcnt(0)" ::: "memory"); SBAR();
#pragma unroll
        for (int dd = 0; dd < 4; ++dd) { p0 = __builtin_amdgcn_mfma_f32_32x32x16_bf16(f0[dd], qr[hf * 4 + dd], p0, 0, 0, 0); p1 = __builtin_amdgcn_mfma_f32_32x32x16_bf16(f1[dd], qr[hf * 4 + dd], p1, 0, 0, 0); }
    }
}
template <int VB>
__device__ __forceinline__ void pv_tile(f32x16* o, int vb0, bf16x8 pa0, bf16x8 pa1, bf16x8 pa2, bf16x8 pa3) {
#define TRRD(dst, off) asm volatile("ds_read_b64_tr_b16 %0, %1 offset:%2" : "=&v"(dst) : "v"(vb0), "i"(off) : "memory")
#define PV_KS(ks, PA) do { s16x4 l0, l1, l2, l3, h0, h1, h2, h3; constexpr int b_ = VB * SHM + v_rd_off(0, ks, 0); \
        TRRD(l0, b_); TRRD(h0, b_ + 2048); TRRD(l1, b_ + 512); TRRD(h1, b_ + 512 + 2048); TRRD(l2, b_ + 1024); TRRD(h2, b_ + 1024 + 2048); TRRD(l3, b_ + 1536); TRRD(h3, b_ + 1536 + 2048); \
        asm volatile("s_waitcnt lgkmcnt(0)" ::: "memory"); SBAR();   \
        o[0] = __builtin_amdgcn_mfma_f32_32x32x16_bf16(PA, (bf16x8){l0[0], l0[1], l0[2], l0[3], h0[0], h0[1], h0[2], h0[3]}, o[0], 0, 0, 0);   \
        o[1] = __builtin_amdgcn_mfma_f32_32x32x16_bf16(PA, (bf16x8){l1[0], l1[1], l1[2], l1[3], h1[0], h1[1], h1[2], h1[3]}, o[1], 0, 0, 0);   \
        o[2] = __builtin_amdgcn_mfma_f32_32x32x16_bf16(PA, (bf16x8){l2[0], l2[1], l2[2], l2[3], h2[0], h2[1], h2[2], h2[3]}, o[2], 0, 0, 0);   \
        o[3] = __builtin_amdgcn_mfma_f32_32x32x16_bf16(PA, (bf16x8){l3[0], l3[1], l3[2], l3[3], h3[0], h3[1], h3[2], h3[3]}, o[3], 0, 0, 0); } while (0)
    PV_KS(0, pa0); PV_KS(1, pa1); PV_KS(2, pa2); PV_KS(3, pa3);
#undef PV_KS
#undef TRRD
}

__device__ __forceinline__ void prompt_units(char* lds, const bf16* Q, const bf16* Kt, const bf16* Vt, const bf16* SZB, bf16* YB, const float* rel, int it0, int stride, int nit) {
    const int tid = threadIdx.x, wid = __builtin_amdgcn_readfirstlane(tid >> 6), lane = tid & 63, r32 = lane & 31, hi = lane >> 5;
    char* V_lds = lds + OFF_V; char* K_lds = lds + OFF_K; float* tab = (float*)(lds + OFF_TAB);
    float* wsx = (float*)(lds + OFF_WS) + wid * 64; float* li_l = wsx, * al_l = wsx + 32;
    const int sr = tid >> 4, sc = (tid & 15) * 8, vst0 = v_st(sr, sc), vst1 = v_st(32 + sr, sc), kws = KSWZ(sr, sc * 2);
    const int vb0 = (int)(uintptr_t)V_lds + v_rd_base(lane);
    const int qo = 32 * (wid & 1) + r32;
    if (it0 >= nit) return;
    bf16x8 qr[8], st_k0, st_k1, st_v0, st_v1;
#define JLO(qb_) ((4 * (qb_) - 8) > 0 ? (4 * (qb_) - 8) : 0)
#define QLOAD(b_, h_, qb_) do { const bf16* qp_ = Q + (size_t)((b_) * SEQ + (qb_) * 256 + wid * 32 + r32) * DBR + (h_) * HD; \
        _Pragma("unroll") for (int d0 = 0; d0 < 8; ++d0) qr[d0] = *reinterpret_cast<const bf16x8*>(qp_ + d0 * 16 + hi * 8); } while (0)
#define SLOAD(Kp, Vp, k0) do { st_v0 = *reinterpret_cast<const bf16x8*>((Vp) + (size_t)((k0) + sr) * DBR); st_v1 = *reinterpret_cast<const bf16x8*>((Vp) + (size_t)((k0) + 32 + sr) * DBR); \
                               st_k0 = *reinterpret_cast<const bf16x8*>((Kp) + (size_t)((k0) + sr) * DBR); st_k1 = *reinterpret_cast<const bf16x8*>((Kp) + (size_t)((k0) + 32 + sr) * DBR); } while (0)
#define SWRITE(bf) do { *(bf16x8*)(V_lds + (bf) * SHM + vst0) = st_v0; *(bf16x8*)(V_lds + (bf) * SHM + vst1) = st_v1; \
                        *(bf16x8*)(K_lds + (bf) * SHM + kws) = st_k0; *(bf16x8*)(K_lds + (bf) * SHM + kws + 32 * 256) = st_k1; } while (0)
    int it = it0, hprev = -1;
    { const int qb = it >> 7, bh = it & 127, b = bh >> 4, h = bh & 15;
      QLOAD(b, h, qb); SLOAD(Kt + (size_t)(b * SEQ) * DBR + h * HD + sc, Vt + (size_t)(b * SEQ) * DBR + h * HD + sc, JLO(qb) * 64);
      if (tid < NREL) tab[tid] = rel[h * NREL + tid] * (1.0f / SCALE); hprev = h;
      SWRITE(0); __syncthreads(); }
    for (;;) {
        const int qb = it >> 7, bh = it & 127, b = bh >> 4, h = bh & 15;
        const int rowbase = b * SEQ + qb * 256;
        const int j_lo = JLO(qb), NT = 4 * qb + 4 - j_lo;
        const int cw = 4 * qb + (wid >> 1);
        const bf16* Kh = Kt + (size_t)(b * SEQ) * DBR + h * HD + sc; const bf16* Vh = Vt + (size_t)(b * SEQ) * DBR + h * HD + sc;
        float m_reg = -1e30f, l_reg = 0.f; f32x16 o[4] = {};
        const float tab256 = tab[256];
#define STEP(t, BUF) do { \
        if ((t) + 1 < NT) SLOAD(Kh, Vh, (j_lo + (t) + 1) * 64); \
        const int cd = cw - (j_lo + (t)); \
        if (cd >= 0 && cd <= 8) { \
            f32x16 p0, p1; \
            if (cd >= 3) { _Pragma("unroll") for (int r = 0; r < 16; ++r) { p0[r] = tab256; p1[r] = tab256; } } \
            else { const int dq = 64 * cd + qo - 4 * hi + 128; \
                _Pragma("unroll") for (int r = 0; r < 16; ++r) { const int c = (r & 3) + 8 * (r >> 2); int i0 = dq - c, i1 = dq - c - 32; i0 = i0 > 256 ? 256 : i0; i1 = i1 > 256 ? 256 : i1; p0[r] = tab[i0]; p1[r] = tab[i1]; } } \
            SBAR(); qkt<BUF>(p0, p1, K_lds, r32, hi, qr); \
            float mn, al; partialSM(p0, p1, m_reg, mn, al); \
            if (__any(al < 1.f)) { if (hi == 0) al_l[r32] = al; LDS_WAIT(); \
                _Pragma("unroll") for (int d_ = 0; d_ < 4; ++d_) _Pragma("unroll") for (int r = 0; r < 16; ++r) o[d_][r] *= al_l[crow(r, hi)]; } \
            bf16x8 pa0, pa1, pa2, pa3; finishSM(p0, p1, al, l_reg, pa0, pa1, pa2, pa3); SBAR(); \
            pv_tile<BUF>(o, vb0, pa0, pa1, pa2, pa3); \
        } \
        if ((t) + 1 < NT) SWRITE((BUF) ^ 1); \
        __syncthreads(); } while (0)
        for (int t = 0; t < NT; t += 2) { STEP(t, 0); STEP(t + 1, 1); }
#undef STEP
        const int itn = it + stride; const bool more = itn < nit;
        if (more) { const int qbn = itn >> 7, bhn = itn & 127, bn = bhn >> 4, hn = bhn & 15;
            QLOAD(bn, hn, qbn); SLOAD(Kt + (size_t)(bn * SEQ) * DBR + hn * HD + sc, Vt + (size_t)(bn * SEQ) * DBR + hn * HD + sc, JLO(qbn) * 64); }
        if (hi == 0) li_l[r32] = l_reg; LDS_WAIT();
        float rli[16];
#pragma unroll
        for (int r = 0; r < 16; ++r) rli[r] = __builtin_amdgcn_rcpf(li_l[crow(r, hi)]);
        const int odd = r32 & 1;
        unsigned zp[16][2];
#pragma unroll
        for (int r = 0; r < 16; ++r) { const size_t go = (size_t)(rowbase + wid * 32 + crow(r, hi)) * DBR + h * HD + (r32 - odd) + odd * 32;
#pragma unroll
            for (int p = 0; p < 2; ++p) zp[r][p] = *(const unsigned*)(SZB + go + p * 64); }
#pragma unroll
        for (int r = 0; r < 16; ++r) { const size_t go = (size_t)(rowbase + wid * 32 + crow(r, hi)) * DBR + h * HD + (r32 - odd) + odd * 32;
#pragma unroll
            for (int p = 0; p < 2; ++p) { const float va = o[2 * p][r] * rli[r], vb = o[2 * p + 1][r] * rli[r];
                const float keep = odd ? vb : va, recv = __shfl_xor(odd ? va : vb, 1);
                const float lo = odd ? recv : keep, hi_ = odd ? keep : recv;
                *(unsigned*)(YB + go + p * 64) = cvt_pk_bf16(lo * bf_lo(zp[r][p]), hi_ * bf_hi(zp[r][p])); } }
        __syncthreads();
        if (!more) break;
        { const int hn = (itn & 127) & 15; if (hn != hprev) { if (tid < NREL) tab[tid] = rel[hn * NREL + tid] * (1.0f / SCALE); hprev = hn; } }
        SWRITE(0);
        __syncthreads();
        it = itn;
    }
#undef JLO
#undef QLOAD
#undef SLOAD
#undef SWRITE
}

constexpr int S_OFF_P = 0, S_OFF_ML = 8 * 80 * 16 * 4, S_OFF_OW = S_OFF_ML + 8 * 32 * 4 + 0, S_LDS_NEED = S_OFF_OW + 8 * 16 * 128 * 4;
__device__ __forceinline__ void sample_unit(char* lds, const bf16* Q, const bf16* Kt, const bf16* Vt, const bf16* SZB, bf16* YB, const float* ck, const float* cv, const float* rel, int b, int h) {
    const int tid = threadIdx.x, wid = __builtin_amdgcn_readfirstlane(tid >> 6), lane = tid & 63, l15 = lane & 15, kq = lane >> 4;
    float* Pw = (float*)(lds + S_OFF_P) + wid * 80 * 16; float* ML = (float*)(lds + S_OFF_ML); float* OW = (float*)(lds + S_OFF_OW);
    const int rowbase = MP + b * DECT;
    constexpr float L2E = 1.4426950408889634f;
    bf16x8 qf[4];
#pragma unroll
    for (int ks = 0; ks < 4; ++ks) qf[ks] = *reinterpret_cast<const bf16x8*>(Q + (size_t)(rowbase + l15) * DBR + h * HD + ks * 32 + kq * 8);
    const float* relh = rel + h * NREL;
    const int nblk = (wid == 0) ? 5 : 4;
    float sc[5][4];
#pragma unroll
    for (int kb = 0; kb < 5; ++kb) { if (kb < nblk) {
        f32x4 acc = {0.f, 0.f, 0.f, 0.f};
        if (kb < 4) { const float* kp = ck + ((size_t)(b * CACHE + wid * 64 + kb * 16 + l15) * NH + h) * HD + kq * 8;
#pragma unroll
            for (int ks = 0; ks < 4; ++ks) { const f32x4 x0 = *(const f32x4*)(kp + ks * 32), x1 = *(const f32x4*)(kp + ks * 32 + 4);
                v4u w = {cvt_pk_bf16(x0[0], x0[1]), cvt_pk_bf16(x0[2], x0[3]), cvt_pk_bf16(x1[0], x1[1]), cvt_pk_bf16(x1[2], x1[3])};
                acc = __builtin_amdgcn_mfma_f32_16x16x32_bf16(*reinterpret_cast<bf16x8*>(&w), qf[ks], acc, 0, 0, 0); } }
        else { const bf16* kp = Kt + (size_t)(rowbase + l15) * DBR + h * HD + kq * 8;
#pragma unroll
            for (int ks = 0; ks < 4; ++ks) acc = __builtin_amdgcn_mfma_f32_16x16x32_bf16(*reinterpret_cast<const bf16x8*>(kp + ks * 32), qf[ks], acc, 0, 0, 0); }
#pragma unroll
        for (int i = 0; i < 4; ++i) { int d;
            if (kb < 4) d = l15 + CACHE - (wid * 64 + kb * 16 + 4 * kq + i); else d = l15 - (4 * kq + i);
            d = d > 128 ? 128 : d; sc[kb][i] = (acc[i] * SCALE + relh[d + 128]) * L2E; }
    } else {
#pragma unroll
        for (int i = 0; i < 4; ++i) sc[kb][i] = -1e30f; } }
    float mx = -1e30f;
#pragma unroll
    for (int kb = 0; kb < 5; ++kb)
#pragma unroll
        for (int i = 0; i < 4; ++i) mx = fmaxf(mx, sc[kb][i]);
    mx = fmaxf(mx, __shfl_xor(mx, 16)); mx = fmaxf(mx, __shfl_xor(mx, 32));
    float ls = 0.f;
#pragma unroll
    for (int kb = 0; kb < 5; ++kb)
#pragma unroll
        for (int i = 0; i < 4; ++i) { const float p = (kb < nblk) ? __builtin_amdgcn_exp2f(sc[kb][i] - mx) : 0.f; ls += p; if (kb < nblk) Pw[(kb * 16 + 4 * kq + i) * 16 + l15] = p; }
    ls += __shfl_xor(ls, 16); ls += __shfl_xor(ls, 32);
    if (kq == 0) { ML[wid * 32 + l15] = mx; ML[wid * 32 + 16 + l15] = ls; }
    LDS_WAIT();
    f32x2 ov[16];
#pragma unroll
    for (int q = 0; q < 16; ++q) ov[q] = (f32x2){0.f, 0.f};
    const float* vp = cv + ((size_t)(b * CACHE + wid * 64) * NH + h) * HD + 2 * lane;
#pragma unroll 4
    for (int k = 0; k < 64; ++k) { const f32x2 v = *(const f32x2*)(vp + (size_t)k * NH * HD); const f32x4* pr = (const f32x4*)(Pw + k * 16);
#pragma unroll
        for (int q4 = 0; q4 < 4; ++q4) { const f32x4 p = pr[q4];
            ov[4 * q4 + 0] += v * p[0]; ov[4 * q4 + 1] += v * p[1]; ov[4 * q4 + 2] += v * p[2]; ov[4 * q4 + 3] += v * p[3]; } }
    if (wid == 0) {
        for (int k = 0; k < 16; ++k) { const unsigned vw = *(const unsigned*)(Vt + (size_t)(rowbase + k) * DBR + h * HD + 2 * lane); const f32x2 v = {bf_lo(vw), bf_hi(vw)}; const f32x4* pr = (const f32x4*)(Pw + (64 + k) * 16);
#pragma unroll
            for (int q4 = 0; q4 < 4; ++q4) { const f32x4 p = pr[q4];
                ov[4 * q4 + 0] += v * p[0]; ov[4 * q4 + 1] += v * p[1]; ov[4 * q4 + 2] += v * p[2]; ov[4 * q4 + 3] += v * p[3]; } }
    }
#pragma unroll
    for (int q = 0; q < 16; ++q) *(f32x2*)(OW + (wid * 16 + q) * 128 + 2 * lane) = ov[q];
    __syncthreads();
    { const int q = tid >> 5, d = (tid & 31) * 4; float mw[8], Mx = -1e30f;
#pragma unroll
      for (int w = 0; w < 8; ++w) { mw[w] = ML[w * 32 + q]; Mx = fmaxf(Mx, mw[w]); }
      float L = 0.f; f32x4 a = {0.f, 0.f, 0.f, 0.f};
#pragma unroll
      for (int w = 0; w < 8; ++w) { const float e = __builtin_amdgcn_exp2f(mw[w] - Mx); L += e * ML[w * 32 + 16 + q]; a += *(const f32x4*)(OW + (w * 16 + q) * 128 + d) * e; }
      const float rl = 1.0f / L; const size_t go = (size_t)(rowbase + q) * DBR + h * HD + d;
      const v2u z = *(const v2u*)(SZB + go);
      v2u w2; w2.x = cvt_pk_bf16(a[0] * rl * bf_lo(z.x), a[1] * rl * bf_hi(z.x)); w2.y = cvt_pk_bf16(a[2] * rl * bf_lo(z.y), a[3] * rl * bf_hi(z.y));
      *(v2u*)(YB + go) = w2; }
    __syncthreads();
}
}

namespace sgu {
constexpr int PITCH = 272;
constexpr int OFF_VNT = 0, OFF_W = 256 * PITCH, LDS_NEED = OFF_W + 128 * PITCH;
__device__ __forceinline__ void prompt_unit(LAS unsigned char* lds, const bf16* VN, const bf16* UZ, bf16* YA, const bf16* Wm, const float* bs, int b, int n, int g) {
    const int tid = threadIdx.x, wid = __builtin_amdgcn_readfirstlane(tid >> 6), lane = tid & 63, r32 = lane & 31, hi = lane >> 5;
    const int row0 = b * SEQ + n * GCH, c0 = g * GDIM;
#pragma unroll
    for (int it = 0; it < 4; ++it) { const int p = tid + it * 512, r = p >> 4, cpc = p & 15;
        *(LAS v4u*)(lds + OFF_W + r * PITCH + cpc * 16) = *(const v4u*)(Wm + (size_t)g * GCH * GCH + r * GCH + cpc * 8); }
#pragma unroll
    for (int it = 0; it < 4; ++it) { const int cg = wid * 4 + it, jj = lane;
        const v4u a = *(const v4u*)(VN + (size_t)(row0 + 2 * jj) * DBR + c0 + cg * 8), bb = *(const v4u*)(VN + (size_t)(row0 + 2 * jj + 1) * DBR + c0 + cg * 8);
        LAS unsigned char* dst = lds + OFF_VNT + (cg * 8) * PITCH + jj * 4;
        *(LAS unsigned*)(dst + 0 * PITCH) = (a.x & 0xffffu) | (bb.x << 16); *(LAS unsigned*)(dst + 1 * PITCH) = (a.x >> 16) | (bb.x & 0xffff0000u);
        *(LAS unsigned*)(dst + 2 * PITCH) = (a.y & 0xffffu) | (bb.y << 16); *(LAS unsigned*)(dst + 3 * PITCH) = (a.y >> 16) | (bb.y & 0xffff0000u);
        *(LAS unsigned*)(dst + 4 * PITCH) = (a.z & 0xffffu) | (bb.z << 16); *(LAS unsigned*)(dst + 5 * PITCH) = (a.z >> 16) | (bb.z & 0xffff0000u);
        *(LAS unsigned*)(dst + 6 * PITCH) = (a.w & 0xffffu) | (bb.w << 16); *(LAS unsigned*)(dst + 7 * PITCH) = (a.w >> 16) | (bb.w & 0xffff0000u); }
    __syncthreads();
    f32x16 acc[4] = {};
#pragma unroll
    for (int ks = 0; ks < 8; ++ks) {
        const bf16x8 a = *(const LAS bf16x8*)(lds + OFF_VNT + (wid * 32 + r32) * PITCH + (ks * 16 + hi * 8) * 2);
#pragma unroll
        for (int ib = 0; ib < 4; ++ib) { if (ib < 2 && ks >= 4) continue;
            const bf16x8 w = *(const LAS bf16x8*)(lds + OFF_W + (ib * 32 + r32) * PITCH + (ks * 16 + hi * 8) * 2);
            acc[ib] = __builtin_amdgcn_mfma_f32_32x32x16_bf16(a, w, acc[ib], 0, 0, 0); } }
    v2u uu[4][4]; float bsv[4];
#pragma unroll
    for (int ib = 0; ib < 4; ++ib) { const int i = ib * 32 + r32; bsv[ib] = bs[g * GCH + i]; const size_t ro = (size_t)(row0 + i) * DBR + c0 + wid * 32 + 4 * hi;
#pragma unroll
        for (int rq = 0; rq < 4; ++rq) uu[ib][rq] = *(const v2u*)(UZ + ro + 8 * rq); }
#pragma unroll
    for (int ib = 0; ib < 4; ++ib) { const int i = ib * 32 + r32; const float bsi = bsv[ib]; const size_t ro = (size_t)(row0 + i) * DBR + c0 + wid * 32 + 4 * hi;
#pragma unroll
        for (int rq = 0; rq < 4; ++rq) { const size_t go = ro + 8 * rq; const v2u u2 = uu[ib][rq];
            const float y0 = bf_lo(u2.x) * (acc[ib][4 * rq + 0] + bsi), y1 = bf_hi(u2.x) * (acc[ib][4 * rq + 1] + bsi);
            const float y2 = bf_lo(u2.y) * (acc[ib][4 * rq + 2] + bsi), y3 = bf_hi(u2.y) * (acc[ib][4 * rq + 3] + bsi);
            v2u w2; w2.x = cvt_pk_bf16(y0, y1); w2.y = cvt_pk_bf16(y2, y3); *(v2u*)(YA + go) = w2; } }
    __syncthreads();
}
__device__ __forceinline__ void sample_unit(const bf16* VN, const bf16* UZ, bf16* YA, const float* w_s, const float* bs, int b, int iq) {
    const int tid = threadIdx.x, c = tid * 4, g = c >> 8; const int row0 = MP + b * DECT;
    f32x4 v[16];
#pragma unroll
    for (int j = 0; j < 16; ++j) { const v2u x = *(const v2u*)(VN + (size_t)(row0 + j) * DBR + c); v[j] = (f32x4){bf_lo(x.x), bf_hi(x.x), bf_lo(x.y), bf_hi(x.y)}; }
    v2u uq[4];
#pragma unroll
    for (int ii = 0; ii < 4; ++ii) { const size_t go = (size_t)(row0 + iq * 4 + ii) * DBR + c; uq[ii] = *(const v2u*)(UZ + go); }
#pragma unroll
    for (int ii = 0; ii < 4; ++ii) { const int i = iq * 4 + ii; const float* wr = w_s + ((size_t)g * GCH + i) * GCH; const float bsi = bs[g * GCH + i]; f32x4 a = {bsi, bsi, bsi, bsi};
        const size_t go = (size_t)(row0 + i) * DBR + c; const v2u u2 = uq[ii];
#pragma unroll
        for (int j = 0; j < 16; ++j) a += v[j] * wr[j];
        v2u w2; w2.x = cvt_pk_bf16(bf_lo(u2.x) * a[0], bf_hi(u2.x) * a[1]); w2.y = cvt_pk_bf16(bf_lo(u2.y) * a[2], bf_hi(u2.y) * a[3]);
        *(v2u*)(YA + go) = w2; }
}
}

constexpr int NWAVES = 8;
constexpr int N_PHASES = 8;
constexpr int N_LAUNCHES = MK_N_LAUNCHES;
constexpr int RING_OFF = 0, RING_BYTES = 131072;
constexpr int LDSCTL_OFF = 143360, MISC_OFF = LDSCTL_OFF + 320;
constexpr int LDS_BYTES = 147456;
static_assert(att::LDS_NEED <= LDSCTL_OFF && att::S_LDS_NEED <= LDSCTL_OFF && sgu::LDS_NEED <= LDSCTL_OFF && 8 * 64 * 65 * 4 <= LDSCTL_OFF && MISC_OFF + 128 <= LDS_BYTES, "LDS map");

#define XB_TMO      128
#define XB_XCNT(j)  (256  + 64 * (j))
#define XB_XSUB(j)  (1280 + 64 * (j))
#define XB_XGEN(j)  (2304 + 64 * (j))
#define XB_TOP      3328
#define XB_TOPGEN   3392
#define XCD_BAR_WORDS 3456
#define XB_SPIN_CAP (1u << 18)
__device__ __forceinline__ unsigned xb_ld(unsigned* p)              { return __hip_atomic_load(p, __ATOMIC_RELAXED, __HIP_MEMORY_SCOPE_AGENT); }
__device__ __forceinline__ unsigned xb_add(unsigned* p, unsigned v) { return __hip_atomic_fetch_add(p, v, __ATOMIC_RELAXED, __HIP_MEMORY_SCOPE_AGENT); }
__device__ __forceinline__ unsigned xb_xcc_id() { return (unsigned)__builtin_amdgcn_s_getreg((3 << 11) | 20) & 0xFu; }
#define XB_SPIN(cond, bar) do { unsigned _sp = 0; while (cond) { __builtin_amdgcn_s_sleep(1); \
    if ((++_sp & 255u) == 0u) { if (xb_ld(&(bar)[XB_TMO])) break; if (_sp > XB_SPIN_CAP) { atomicAdd(&(bar)[XB_TMO], 1u); break; } } } } while (0)
struct XcdBarrier { unsigned* bar; unsigned x; volatile LAS unsigned* st; };
__device__ __forceinline__ XcdBarrier xcd_barrier_post(unsigned* bar, volatile LAS unsigned* st) {
    XcdBarrier b; b.bar = bar; b.x = xb_xcc_id(); b.st = st;
    if (threadIdx.x == 0) (void)xb_add(&bar[XB_XCNT(b.x)], 1u);
    return b;
}
__device__ __forceinline__ void xcd_barrier_complete(unsigned* bar, unsigned x, unsigned& nloc, unsigned& nx) {
    const unsigned G = gridDim.x * gridDim.y * gridDim.z;
    unsigned sum, cnt, mine, sp = 0u;
    for (;;) {
        sum = 0u; cnt = 0u; mine = 0u;
#pragma unroll
        for (unsigned j = 0; j < 16; ++j) { const unsigned c = xb_ld(&bar[XB_XCNT(j)]); sum += c; cnt += (c > 0u) ? 1u : 0u; mine = (j == x) ? c : mine; }
        if (sum == G) break;
        __builtin_amdgcn_s_sleep(1);
        if ((++sp & 255u) == 0u) { if (xb_ld(&bar[XB_TMO])) break; if (sp > XB_SPIN_CAP) { atomicAdd(&bar[XB_TMO], 1u); break; } }
    }
    nloc = mine > 0u ? mine : 1u; nx = cnt > 0u ? cnt : 1u;
}
__device__ __forceinline__ void xcd_barrier(const XcdBarrier& b) {
    asm volatile("s_waitcnt vmcnt(0)" ::: "memory");
    __syncthreads();
    if (threadIdx.x == 0) {
        unsigned* bar = b.bar;
        __builtin_amdgcn_s_waitcnt(0);
        unsigned nloc = b.st[0], nx = b.st[1];
        if (nloc == 0u) { xcd_barrier_complete(bar, b.x, nloc, nx); b.st[0] = nloc; b.st[1] = nx; }
        const unsigned old = xb_add(&bar[XB_XSUB(b.x)], 1u);
        const unsigned gen = old / nloc;
        if (old + 1u == (gen + 1u) * nloc) {
            __builtin_amdgcn_fence(__ATOMIC_RELEASE, "agent");
            asm volatile("s_waitcnt vmcnt(0)" ::: "memory");
            const unsigned og = xb_add(&bar[XB_TOP], 1u);
            const unsigned tg = og / nx;
            if (og + 1u == (tg + 1u) * nx) xb_add(&bar[XB_TOPGEN], 1u);
            else XB_SPIN(xb_ld(&bar[XB_TOPGEN]) == tg, bar);
            __builtin_amdgcn_fence(__ATOMIC_ACQUIRE, "agent");
            xb_add(&bar[XB_XGEN(b.x)], 1u);
            asm volatile("s_waitcnt vmcnt(0)" ::: "memory");
        } else {
            XB_SPIN(xb_ld(&bar[XB_XGEN(b.x)]) == gen, bar);
            __builtin_amdgcn_fence(__ATOMIC_ACQUIRE, "agent");
            asm volatile("s_waitcnt vmcnt(0)" ::: "memory");
        }
    }
    __syncthreads();
}

__device__ __forceinline__ int win_src_col(int np) {
    if (np < 2 * DBR) { const int c4 = np >> 3, e = np & 3, hf = (np >> 2) & 1; return (hf ? 2 * DBR : 0) + 4 * c4 + e; }
    if (np < 3 * DBR) return np - 2 * DBR + DBR;
    if (np < 7 * DBR) return np;
    { const int m = np - 7 * DBR, c4 = m >> 3, e = m & 3, hf = (m >> 2) & 1; return 7 * DBR + (hf ? DM : 0) + 4 * c4 + e; }
}
template <bool PERMC>
__device__ __forceinline__ void transpose_item(const float* W, int K, int N, bf16* WT, LAS float* scr, int item, int lane) {
    const int nblk = N / 64, kb = item / nblk, nb = item % nblk, k0 = 64 * kb, n0 = 64 * nb;
    const float* src = W + (size_t)k0 * N + (PERMC ? win_src_col(n0 + lane) : n0 + lane);
    float v[64];
#pragma unroll
    for (int i = 0; i < 64; ++i) v[i] = src[(size_t)i * N];
#pragma unroll
    for (int i = 0; i < 64; ++i) scr[i * 65 + lane] = v[i];
    LDS_WAIT(); asm volatile("" ::: "memory");
    const int c = lane & 7;
#pragma unroll
    for (int j = 0; j < 8; ++j) { const int n = (lane >> 3) + 8 * j; const LAS float* s = scr + (8 * c) * 65 + n;
        v4u o; o.x = cvt_pk_bf16(s[0 * 65], s[1 * 65]); o.y = cvt_pk_bf16(s[2 * 65], s[3 * 65]); o.z = cvt_pk_bf16(s[4 * 65], s[5 * 65]); o.w = cvt_pk_bf16(s[6 * 65], s[7 * 65]);
        *(v4u*)(WT + (size_t)(n0 + n) * K + k0 + 8 * c) = o; }
    LDS_WAIT(); asm volatile("" ::: "memory");
}
#define RMS_LOAD(V, xrow_) do { const f32x4* xr_ = (const f32x4*)(xrow_) + lane; _Pragma("unroll") for (int j = 0; j < 16; ++j) V[j] = xr_[64 * j]; } while (0)
#define RMS_PROC(V, orow_) do { float s_ = 0.f; _Pragma("unroll") for (int j = 0; j < 16; ++j) s_ += (V[j].x * V[j].x + V[j].y * V[j].y) + (V[j].z * V[j].z + V[j].w * V[j].w); \
        const float r_ = 1.0f / sqrtf(wave_sum(s_) * (1.f / DM) + EPS); v2u* o8_ = (v2u*)(orow_) + lane; \
        _Pragma("unroll") for (int j = 0; j < 16; ++j) { const f32x4 gg = ((const LAS f32x4*)gl)[lane + 64 * j]; v2u w; w.x = cvt_pk_bf16(V[j].x * r_ * gg.x, V[j].y * r_ * gg.y); w.y = cvt_pk_bf16(V[j].z * r_ * gg.z, V[j].w * r_ * gg.w); o8_[64 * j] = w; } } while (0)

struct Args { const float* in[19]; float* out; unsigned char* ws; int ph_lo, ph_hi, li, pad; };

__global__ void __launch_bounds__(NWAVES * 64, 2) fwd_kernel(Args args) {
    extern __shared__ __attribute__((aligned(16))) unsigned char lds_raw[];
    LAS unsigned char* lds = (LAS unsigned char*)lds_raw;
    const int tid = threadIdx.x, lane = tid & 63, wave = __builtin_amdgcn_readfirstlane(tid >> 6);
    const int G = gridDim.x, bx = blockIdx.x;
    const int vcu = (G % 8 == 0) ? (bx % 8) * (G / 8) + bx / 8 : bx;
    unsigned char* ws = args.ws;
    gu32* ctl = (gu32*)(ws + WS_CTL);
    const float* x_prompt = args.in[0]; const float* x_sample = args.in[1]; const float* cache_k = args.in[2]; const float* cache_v = args.in[3];
    const float* p_prompt = args.in[4]; const float* p_sample = args.in[5]; const float* pre_g = args.in[6]; const float* post_g = args.in[7];
    const float* w_in = args.in[8]; const float* ln_g = args.in[9]; const float* ln_b = args.in[10]; const float* w_s = args.in[11]; const float* b_s = args.in[12];
    const float* rel_bias = args.in[13]; const float* w_up_a = args.in[14]; const float* w_up_b = args.in[15]; const float* w_out = args.in[16];
    const float* w_pg = args.in[17]; const float* w_pp = args.in[18];
    float* out = args.out;
    bf16* WIN_T = (bf16*)(ws + WS_WIN); bf16* WUA_T = (bf16*)(ws + WS_WUA); bf16* WUB_T = (bf16*)(ws + WS_WUB); bf16* WOUT_T = (bf16*)(ws + WS_WOUT);
    bf16* WPG_T = (bf16*)(ws + WS_WPG); bf16* WPP_T = (bf16*)(ws + WS_WPP); bf16* WSM = (bf16*)(ws + WS_WS); bf16* PB = (bf16*)(ws + WS_PB);
    bf16* HB = (bf16*)(ws + WS_H); bf16* YA = (bf16*)(ws + WS_H); bf16* YB = (bf16*)(ws + WS_H + SEG2K);
    bf16* SEG = (bf16*)(ws + WS_SEG);
    bf16* GU = SEG; bf16* GV = SEG + (size_t)M * DBR; bf16* SZA = SEG + (size_t)2 * M * DBR; bf16* QB = SEG + (size_t)3 * M * DBR; bf16* KB = SEG + (size_t)4 * M * DBR;
    bf16* VB = SEG + (size_t)5 * M * DBR; bf16* SZB = SEG + (size_t)6 * M * DBR; bf16* SGA = SEG + (size_t)7 * M * DBR; bf16* SGB = SGA + (size_t)M * DM;
    bf16* SLAB = (bf16*)(ws + WS_SLAB); bf16* PBUF = (bf16*)(ws + WS_P); bf16* MBUF = (bf16*)(ws + WS_MBUF); bf16* TB = (bf16*)(ws + WS_T); bf16* X1B = (bf16*)(ws + WS_X1B);

    for (int u = tid; u < (LDS_BYTES - LDSCTL_OFF) / 4; u += NWAVES * 64) ((LAS unsigned*)(lds + LDSCTL_OFF))[u] = 0u;
    __syncthreads();
    volatile LAS unsigned* MISC = (volatile LAS unsigned*)(lds + MISC_OFF);
    XcdBarrier bar; bar.bar = (unsigned*)(ctl + CW_BAR); bar.x = 0; bar.st = nullptr;
    if (N_LAUNCHES == 1) bar = xcd_barrier_post((unsigned*)(ctl + CW_BAR), MISC + 8);
#define GRID_BAR() do { if (N_LAUNCHES == 1) xcd_barrier(bar); } while (0)
    const int lo = args.ph_lo, hi = args.ph_hi;
#define IN(k) (lo <= (k) && (k) < hi)
#define BOTH(k) (IN(k) && IN((k) + 1))
    const int gw = vcu * NWAVES + wave, NGW = G * NWAVES;

    if (IN(0)) {
        LAS float* scr = (LAS float*)(lds + wave * (64 * 65 * 4));
        constexpr int I_IN = (DM / 64) * (NIN / 64), I_UP = (DBR / 64) * (DM / 64), I_SQ = (DM / 64) * (DM / 64), I_PP = (PLE / 64) * (DM / 64);
        constexpr int NITEMS = I_IN + 2 * I_UP + 2 * I_SQ + I_PP;
        for (int it = gw; it < NITEMS; it += NGW) {
            int r = it;
            if (r < I_IN) { transpose_item<true>(w_in, DM, NIN, WIN_T, scr, r, lane); continue; } r -= I_IN;
            if (r < I_UP) { transpose_item<false>(w_up_a, DBR, DM, WUA_T, scr, r, lane); continue; } r -= I_UP;
            if (r < I_UP) { transpose_item<false>(w_up_b, DBR, DM, WUB_T, scr, r, lane); continue; } r -= I_UP;
            if (r < I_SQ) { transpose_item<false>(w_out, DM, DM, WOUT_T, scr, r, lane); continue; } r -= I_SQ;
            if (r < I_SQ) { transpose_item<false>(w_pg, DM, DM, WPG_T, scr, r, lane); continue; } r -= I_SQ;
            transpose_item<false>(w_pp, PLE, DM, WPP_T, scr, r, lane);
        }
        { __syncthreads();
          LAS float* gl = (LAS float*)lds;
          for (int i = tid; i < DM / 4; i += NWAVES * 64) ((LAS f32x4*)gl)[i] = ((const f32x4*)pre_g)[i];
          __syncthreads();
#define XROW(m_) ((m_) < MP ? x_prompt + (size_t)(m_) * DM : x_sample + (size_t)((m_) - MP) * DM)
          const int m0 = (NGW == 2048 ? ((gw + 1024) & 2047) : gw);
          f32x4 va[16], vb[16];
          if (m0 < M) RMS_LOAD(va, XROW(m0));
          for (int m = m0; m < M; m += 2 * NGW) {
              if (m + NGW < M) RMS_LOAD(vb, XROW(m + NGW));
              asm volatile("" ::: "memory");
              RMS_PROC(va, HB + (size_t)m * DM);
              if (m + NGW < M) { if (m + 2 * NGW < M) RMS_LOAD(va, XROW(m + 2 * NGW));
                  asm volatile("" ::: "memory");
                  RMS_PROC(vb, HB + (size_t)(m + NGW) * DM); } }
#undef XROW
        }
        { const int gt = vcu * 512 + tid, NT_ = G * 512;
          for (int i = gt; i < M * PLE / 4; i += NT_) { const int m = (i * 4) / PLE; const f32x4 v = (m < MP) ? ((const f32x4*)p_prompt)[i] : ((const f32x4*)p_sample)[i - MP * PLE / 4];
              v2u w; w.x = cvt_pk_bf16(v.x, v.y); w.y = cvt_pk_bf16(v.z, v.w); ((v2u*)PB)[i] = w; }
          for (int i = gt; i < NGRP * GCH * GCH; i += NT_) { const int ii = (i >> 7) & 127, jj = i & 127; const float v = ((jj >> 6) <= (ii >> 6)) ? w_s[i] : 0.f; WSM[i] = (bf16)(cvt_pk_bf16(v, 0.f) & 0xffffu); } }
        if (BOTH(0)) GRID_BAR();
    }
    if (IN(1)) {
#pragma unroll 1
        for (int pass = 0; pass < 2; ++pass) {
            const int pmo = pass ? MP / 256 : 0; const bf16* Ap = HB + (size_t)pmo * 256 * DM;
            pg8::Order S; S.init(Ap, WIN_T, Ap, WIN_T, DM, DM, pass ? MS : MP, NIN, DM, 1, G, bx, 0, 0, 0);
            pg8::EpiIn E{SEG, out, pmo};
            pg8::gemm_phase<pg8::EpiIn, false>(lds + RING_OFF, S, E);
        }
#pragma unroll 1
        for (int part = 0; part < 2; ++part) {
            const bool split = (G == 256);
            pg8::Order S; S.init(PB, WPP_T, PB, WPP_T, PLE, PLE, M, DM, PLE, 1, (split && !part) ? 80 : G, (split && !part) ? bx - 176 : bx, 0, 0, 0);
            if (split) S.set_range(part ? 800 : 0, part ? 1056 : 800); else if (part) S.set_range(0, 0);
            pg8::EpiStore E{PBUF, DM, nullptr, 0};
            pg8::gemm_phase<pg8::EpiStore>(lds + RING_OFF, S, E);
        }
        if (BOTH(1)) GRID_BAR();
    }
    if (IN(2)) {
        f32x4 lg[4][2], lb[4][2];
#pragma unroll
        for (int j = 0; j < 4; ++j) { const int c = (lane + 64 * j) * 8; lg[j][0] = *(const f32x4*)(ln_g + c); lg[j][1] = *(const f32x4*)(ln_g + c + 4); lb[j][0] = *(const f32x4*)(ln_b + c); lb[j][1] = *(const f32x4*)(ln_b + c + 4); }
        for (int m = gw; m < M; m += NGW) {
            v4u* rp = (v4u*)(GV + (size_t)m * DBR) + lane;
            float v[32]; float s = 0.f;
#pragma unroll
            for (int j = 0; j < 4; ++j) { const v4u w = rp[64 * j]; v[8 * j + 0] = bf_lo(w.x); v[8 * j + 1] = bf_hi(w.x); v[8 * j + 2] = bf_lo(w.y); v[8 * j + 3] = bf_hi(w.y);
                v[8 * j + 4] = bf_lo(w.z); v[8 * j + 5] = bf_hi(w.z); v[8 * j + 6] = bf_lo(w.w); v[8 * j + 7] = bf_hi(w.w); }
#pragma unroll
            for (int j = 0; j < 32; ++j) s += v[j];
            const float mean = wave_sum(s) * (1.f / DBR); float s2 = 0.f;
#pragma unroll
            for (int j = 0; j < 32; ++j) { v[j] -= mean; s2 += v[j] * v[j]; }
            const float rstd = 1.0f / sqrtf(wave_sum(s2) * (1.f / DBR) + EPS);
            float* fo = nullptr;
            if (m >= MP) fo = out + OFF_GS + (size_t)(m - MP) * DBR; else if ((m & (SEQ - 1)) >= SEQ - GCH) fo = out + OFF_GP + (size_t)((m >> 11) * GCH + (m & (SEQ - 1)) - (SEQ - GCH)) * DBR;
#pragma unroll
            for (int j = 0; j < 4; ++j) { const int c = (lane + 64 * j) * 8; const f32x4 g0 = lg[j][0], g1 = lg[j][1], b0 = lb[j][0], b1 = lb[j][1];
                f32x4 y0, y1; y0[0] = v[8 * j + 0] * rstd * g0[0] + b0[0]; y0[1] = v[8 * j + 1] * rstd * g0[1] + b0[1]; y0[2] = v[8 * j + 2] * rstd * g0[2] + b0[2]; y0[3] = v[8 * j + 3] * rstd * g0[3] + b0[3];
                y1[0] = v[8 * j + 4] * rstd * g1[0] + b1[0]; y1[1] = v[8 * j + 5] * rstd * g1[1] + b1[1]; y1[2] = v[8 * j + 6] * rstd * g1[2] + b1[2]; y1[3] = v[8 * j + 7] * rstd * g1[3] + b1[3];
                if (fo) { *(f32x4*)(fo + c) = y0; *(f32x4*)(fo + c + 4) = y1; }
                v4u w; w.x = cvt_pk_bf16(y0[0], y0[1]); w.y = cvt_pk_bf16(y0[2], y0[3]); w.z = cvt_pk_bf16(y1[0], y1[1]); w.w = cvt_pk_bf16(y1[2], y1[3]); rp[64 * j] = w; }
        }
        if (BOTH(2)) GRID_BAR();
    }
    if (IN(3)) {
        att::prompt_units((char*)lds_raw, QB, KB, VB, SZB, YB, rel_bias, bx, G, NB * NH * 8);
        for (int it = bx; it < DECB * NH; it += G) att::sample_unit((char*)lds_raw, QB, KB, VB, SZB, YB, cache_k, cache_v, rel_bias, it >> 4, it & 15);
        for (int it = bx; it < NB * 16 * NGRP; it += G) sgu::prompt_unit(lds, GV, GU, YA, WSM, b_s, it >> 7, (it >> 3) & 15, it & 7);
        for (int it = bx; it < DECB * 4; it += (G == 256 ? 128 : G)) { if (G == 256 && bx >= 128) break; sgu::sample_unit(GV, GU, YA, w_s, b_s, it >> 2, it & 3); }
        if (BOTH(3)) GRID_BAR();
    }
    if (IN(4)) {
        { pg8::Order S; S.init(YA, WUA_T, YB, WUB_T, DBR, DBR, MP, DM, DBR, 2, G, bx, 0, 0, 0);
          pg8::EpiMerge E{SGA, SGB, MBUF};
          pg8::gemm_phase<pg8::EpiMerge>(lds + RING_OFF, S, E); }
        { pg8::Order S; S.init(YA, WUA_T, YB, WUB_T, DBR, DBR, 0, DM, DBR, 2, G, bx, MS, 8, MP / 256);
          pg8::EpiMergeSub E{SGA, SGB, SLAB, MP / 256};
          pg8::gemm_phase<pg8::EpiMergeSub>(lds + RING_OFF, S, E); }
        GRID_BAR();
        for (int i = vcu * 512 + tid; i < MS * DM / 8; i += G * 512) { f32x4 a0 = {0.f, 0.f, 0.f, 0.f}, a1 = a0;
#pragma unroll
            for (int k = 0; k < 8; ++k) { const v4u p = *(const v4u*)(SLAB + (size_t)k * (MS * DM) + (size_t)i * 8); a0 += (f32x4){bf_lo(p.x), bf_hi(p.x), bf_lo(p.y), bf_hi(p.y)}; a1 += (f32x4){bf_lo(p.z), bf_hi(p.z), bf_lo(p.w), bf_hi(p.w)}; }
            v4u w; w.x = cvt_pk_bf16(a0[0], a0[1]); w.y = cvt_pk_bf16(a0[2], a0[3]); w.z = cvt_pk_bf16(a1[0], a1[1]); w.w = cvt_pk_bf16(a1[2], a1[3]);
            *(v4u*)(MBUF + (size_t)MP * DM + (size_t)i * 8) = w; }
        if (BOTH(4)) GRID_BAR();
    }
    if (IN(5)) {
        pg8::Order S; S.init(MBUF, WOUT_T, MBUF, WOUT_T, DM, DM, MP, DM, DM, 1, G, bx, MS, 8, MP / 256); S.sub_first = bx & 1;
        pg8::EpiStore E{TB, DM, SLAB, MP / 256};
        pg8::gemm_phase<pg8::EpiStore>(lds + RING_OFF, S, E);
        if (BOTH(5)) GRID_BAR();
    }
    if (IN(6)) {
        f32x4 pg[8][2];
#pragma unroll
        for (int j = 0; j < 8; ++j) { const int c = (lane + 64 * j) * 8; pg[j][0] = *(const f32x4*)(post_g + c); pg[j][1] = *(const f32x4*)(post_g + c + 4); }
        const bool deal = (NGW == 2048); const int own_s = deal && gw < MS;
        const int r0 = deal ? (gw < MS ? gw * 5 : MS * 5 + (gw - MS) * 9) : gw, nrow = deal ? (gw < MS ? 6 : 9) : (M - gw + NGW - 1) / NGW;
        for (int j = 0; j < nrow; ++j) {
            const int m = deal ? ((own_s && j == 0) ? MP + gw : r0 + j - own_s) : gw + j * NGW;
            const float* xrow = m < MP ? x_prompt + (size_t)m * DM : x_sample + (size_t)(m - MP) * DM;
            f32x4 t0[8], t1[8], x0[8], x1[8]; float s = 0.f;
#pragma unroll
            for (int j = 0; j < 8; ++j) { const int c = (lane + 64 * j) * 8; x0[j] = *(const f32x4*)(xrow + c); x1[j] = *(const f32x4*)(xrow + c + 4); }
            if (m >= MP) {
#pragma unroll
                for (int j = 0; j < 8; ++j) { const int c = (lane + 64 * j) * 8; f32x4 a0 = {0.f, 0.f, 0.f, 0.f}, a1 = a0;
#pragma unroll
                    for (int k = 0; k < 8; ++k) { const v4u p = *(const v4u*)(SLAB + (size_t)k * (MS * DM) + (size_t)(m - MP) * DM + c); a0 += (f32x4){bf_lo(p.x), bf_hi(p.x), bf_lo(p.y), bf_hi(p.y)}; a1 += (f32x4){bf_lo(p.z), bf_hi(p.z), bf_lo(p.w), bf_hi(p.w)}; }
                    t0[j] = a0; t1[j] = a1; }
            } else {
                const v4u* tp = (const v4u*)(TB + (size_t)m * DM) + lane; v4u tw[8];
#pragma unroll
                for (int j = 0; j < 8; ++j) tw[j] = tp[64 * j];
#pragma unroll
                for (int j = 0; j < 8; ++j) { t0[j] = (f32x4){bf_lo(tw[j].x), bf_hi(tw[j].x), bf_lo(tw[j].y), bf_hi(tw[j].y)}; t1[j] = (f32x4){bf_lo(tw[j].z), bf_hi(tw[j].z), bf_lo(tw[j].w), bf_hi(tw[j].w)}; }
            }
#pragma unroll
            for (int j = 0; j < 8; ++j) { const f32x4 a0 = t0[j], a1 = t1[j]; s += (a0[0] * a0[0] + a0[1] * a0[1]) + (a0[2] * a0[2] + a0[3] * a0[3]) + (a1[0] * a1[0] + a1[1] * a1[1]) + (a1[2] * a1[2] + a1[3] * a1[3]); }
            const float r = 1.0f / sqrtf(wave_sum(s) * (1.f / DM) + EPS);
            float* yo = out + OFF_Y + (size_t)m * DM; v4u* xb = (v4u*)(X1B + (size_t)m * DM) + lane;
#pragma unroll
            for (int j = 0; j < 8; ++j) { const int c = (lane + 64 * j) * 8; const f32x4 y0 = x0[j] + t0[j] * r * pg[j][0], y1 = x1[j] + t1[j] * r * pg[j][1];
                if (m >= MP) { *(f32x4*)(yo + c) = y0; *(f32x4*)(yo + c + 4) = y1; }
                v4u w; w.x = cvt_pk_bf16(y0[0], y0[1]); w.y = cvt_pk_bf16(y0[2], y0[3]); w.z = cvt_pk_bf16(y1[0], y1[1]); w.w = cvt_pk_bf16(y1[2], y1[3]); xb[64 * j] = w; }
        }
        if (BOTH(6)) GRID_BAR();
    }
    if (IN(7)) {
        pg8::Order S; S.init(X1B, WPG_T, X1B, WPG_T, DM, DM, MP, DM, DM, 1, G, bx, MS, 8, MP / 256); S.sub_first = bx & 1;
        pg8::EpiFinal E{out + OFF_Y, PBUF, SLAB, MP / 256, X1B};
        pg8::gemm_phase<pg8::EpiFinal>(lds + RING_OFF, S, E);
        GRID_BAR();
        for (int i = vcu * 512 + tid; i < MS * DM / 4; i += G * 512) { f32x4 a = {0.f, 0.f, 0.f, 0.f};
#pragma unroll
            for (int k = 0; k < 8; ++k) { const v2u p = *(const v2u*)(SLAB + (size_t)k * (MS * DM) + (size_t)i * 4); a += (f32x4){bf_lo(p.x), bf_hi(p.x), bf_lo(p.y), bf_hi(p.y)}; }
            float* yp = out + OFF_Y + (size_t)MP * DM + (size_t)i * 4; const f32x4 x1 = *(const f32x4*)yp; const v2u p = *(const v2u*)(PBUF + (size_t)MP * DM + (size_t)i * 4);
            f32x4 y; y[0] = x1[0] + sigmoid_f(a[0]) * bf_lo(p.x); y[1] = x1[1] + sigmoid_f(a[1]) * bf_hi(p.x); y[2] = x1[2] + sigmoid_f(a[2]) * bf_lo(p.y); y[3] = x1[3] + sigmoid_f(a[3]) * bf_hi(p.y);
            *(f32x4*)yp = y; }
    }
#undef IN
#undef BOTH
#undef GRID_BAR
}

extern "C" void kernel_launch(void* const* d_in, const int* in_sizes, int n_in, void* d_out, int out_size, void* d_ws, size_t ws_size, hipStream_t stream) {
    static int grid = 0;
    if (grid == 0) {
        if (n_in != 19 || (size_t)out_size != OUT_TOTAL || ws_size < WS_END) { fprintf(stderr, "kernel_launch: unexpected shapes: n_in %d out %d ws %zu (need %zu)\n", n_in, out_size, ws_size, (size_t)WS_END); grid = -1; return; }
        int dev = 0, cus = 0, per_cu = 0;
        if (hipGetDevice(&dev) != hipSuccess || hipDeviceGetAttribute(&cus, hipDeviceAttributeMultiprocessorCount, dev) != hipSuccess) { grid = -1; return; }
        if (hipFuncSetAttribute((const void*)fwd_kernel, hipFuncAttributeMaxDynamicSharedMemorySize, LDS_BYTES) != hipSuccess) { fprintf(stderr, "kernel_launch: hipFuncSetAttribute failed\n"); grid = -1; return; }
        if (hipOccupancyMaxActiveBlocksPerMultiprocessor(&per_cu, (const void*)fwd_kernel, NWAVES * 64, LDS_BYTES) != hipSuccess || per_cu < 1)
            fprintf(stderr, "kernel_launch: note: occupancy query reports %d workgroups per CU\n", per_cu);
        (void)hipGetLastError();
        grid = cus;
    }
    if (grid < 0) return;
    if (hipMemsetAsync((char*)d_ws + WS_CTL, 0, CTL_ZERO_BYTES, stream) != hipSuccess) return;
    Args a{};
    for (int i = 0; i < 19; ++i) a.in[i] = (const float*)d_in[i];
    a.out = (float*)d_out; a.ws = (unsigned char*)d_ws;
    for (int li = 0; li < N_LAUNCHES; ++li) {
        a.ph_lo = (N_LAUNCHES == 1) ? 0 : li; a.ph_hi = (N_LAUNCHES == 1) ? N_PHASES : li + 1; a.li = li;
        hipLaunchKernelGGL(fwd_kernel, dim3(grid), dim3(NWAVES * 64), LDS_BYTES, stream, a);
        const hipError_t le = hipPeekAtLastError();
        if (le != hipSuccess) { fprintf(stderr, "kernel_launch: launch %d failed: %s\n", li, hipGetErrorName(le)); break; }
    }
}
```

```cpp
#include <hip/hip_runtime.h>
#include <cstdio>
#include <cstdint>

#ifndef MK_N_LAUNCHES
#define MK_N_LAUNCHES 1
#endif

constexpr int DM = 4096, DBR = 2048, NB = 8, SEQ = 2048, DECB = 32, DECT = 16;
constexpr int MP = NB * SEQ, MS = DECB * DECT, M = MP + MS;
constexpr int NIN = 7 * DBR + 2 * DM;
constexpr int NH = 16, HD = 128, PLE = 256, NGRP = 8, GCH = 128, GDIM = 256, CACHE = 512, NREL = 257;
constexpr float EPS = 1e-6f;
constexpr size_t OFF_Y = 0, OFF_KP = (size_t)M * DM, OFF_VP = OFF_KP + (size_t)NB * 512 * DBR, OFF_KS = OFF_VP + (size_t)NB * 512 * DBR,
                 OFF_VS = OFF_KS + (size_t)MS * DBR, OFF_GP = OFF_VS + (size_t)MS * DBR, OFF_GS = OFF_GP + (size_t)NB * GCH * DBR, OUT_TOTAL = OFF_GS + (size_t)MS * DBR;
constexpr size_t MiB = 1u << 20;
constexpr size_t WS_CTL = 0, CTL_ZERO_BYTES = 1 * MiB;
constexpr size_t WS_WIN = 1 * MiB, WS_WUA = 177 * MiB, WS_WUB = 193 * MiB, WS_WOUT = 209 * MiB, WS_WPG = 241 * MiB, WS_WPP = 273 * MiB, WS_WS = 275 * MiB, WS_PB = 276 * MiB;
constexpr size_t WS_H = 285 * MiB;
constexpr size_t WS_SEG = 417 * MiB;
constexpr size_t SEG2K = (size_t)M * DBR * 2;
constexpr size_t WS_P = 1143 * MiB, WS_SLAB = 1275 * MiB, WS_END = 1339 * MiB;
constexpr size_t WS_MBUF = WS_SEG, WS_T = WS_SEG + 2 * SEG2K, WS_X1B = WS_SEG + 4 * SEG2K;
static_assert(SEG2K == 66 * MiB && WS_SEG + 7 * SEG2K + 4 * SEG2K == WS_P && WS_H + 2 * SEG2K == WS_SEG, "ws map");
constexpr int CW_TMO = 0, CW_BAR = 4096;

#define GAS __attribute__((address_space(1)))
#define LAS __attribute__((address_space(3)))
typedef unsigned short bf16;
typedef unsigned v4u __attribute__((ext_vector_type(4)));
typedef unsigned v2u __attribute__((ext_vector_type(2)));
typedef float f32x4 __attribute__((ext_vector_type(4)));
typedef float f32x2 __attribute__((ext_vector_type(2)));
typedef float f32x16 __attribute__((ext_vector_type(16)));
typedef short bf16x8 __attribute__((ext_vector_type(8)));
typedef short s16x4 __attribute__((ext_vector_type(4)));
typedef GAS unsigned gu32;
#define RLX_AGENT __ATOMIC_RELAXED, __HIP_MEMORY_SCOPE_AGENT
#define LDS_WAIT() asm volatile("s_waitcnt lgkmcnt(0)" ::: "memory")
#define VM_WAIT() asm volatile("s_waitcnt vmcnt(0)" ::: "memory")

typedef __bf16 bf16x2_t __attribute__((ext_vector_type(2)));
__device__ __forceinline__ unsigned cvt_pk_bf16(float lo, float hi) { const f32x2 v = {lo, hi}; return __builtin_bit_cast(unsigned, __builtin_convertvector(v, bf16x2_t)); }
__device__ __forceinline__ float bf_lo(unsigned w) { return __uint_as_float(w << 16); }
__device__ __forceinline__ float bf_hi(unsigned w) { return __uint_as_float(w & 0xffff0000u); }
__device__ __forceinline__ float bf2f(bf16 b) { return __uint_as_float(((unsigned)b) << 16); }
__device__ __forceinline__ float sigmoid_f(float v) { return __builtin_amdgcn_rcpf(1.0f + __builtin_amdgcn_exp2f(-1.4426950408889634f * v)); }
__device__ __forceinline__ float silu_f(float v) { return v * sigmoid_f(v); }
__device__ __forceinline__ f32x2 gelu_pk(f32x2 v) {
    const f32x2 av = __builtin_elementwise_abs(v), d = av * 0.2316418882f + 1.0f;
    f32x2 t; t.x = __builtin_amdgcn_rcpf(d.x); t.y = __builtin_amdgcn_rcpf(d.y);
    f32x2 q = t * 0.5307027145f + (-0.7265760135f); q = q * t + 0.7107068705f; q = q * t + (-0.142248368f); q = q * t + 0.127414796f; q = q * t;
    const f32x2 s = (v * v) * (-0.72134752044f);
    f32x2 e; e.x = __builtin_amdgcn_exp2f(s.x); e.y = __builtin_amdgcn_exp2f(s.y);
    const f32x2 m = v * (q * e), r = v - m;
    f32x2 o; o.x = v.x < 0.f ? m.x : r.x; o.y = v.y < 0.f ? m.y : r.y; return o;
}
__device__ __forceinline__ float wave_sum(float v) {
#pragma unroll
    for (int o = 1; o < 64; o <<= 1) v += __shfl_xor(v, o);
    return v;
}

namespace pg8 {
#define PG8_LAS __attribute__((address_space(3)))
typedef unsigned short bf16_t;
constexpr int BM = 256, BK = 64, HALF = 128, HTB = HALF * BK * 2, STAGE_BYTES = 8 * HTB, NXCD = 8, WGM = 8;
__host__ __device__ __forceinline__ int lds_byte(int r, int c) { const int st = (r >> 4) * 2 + (c >> 5), rr = r & 15, cc = c & 31, ob = rr * 64 + cc * 2; return st * 1024 + (ob ^ (((ob >> 9) & 1) << 5)); }
__host__ __device__ __forceinline__ void stage_rc(int b, int& R, int& C) { const int st = b / 1024, sb = b % 1024, swz = sb ^ (((sb >> 9) & 1) << 5); R = (st >> 1) * 16 + swz / 64; C = (st & 1) * 32 + (swz % 64) / 2; }
__host__ __device__ __forceinline__ int perm32(int rho) { const int n = rho >> 4, i = rho & 15; return 8 * (i >> 2) + 4 * n + (i & 3); }

struct Unit { int pm, pn, seg, kind, ks, nt; const char* a; const char* b; };
struct Order {
    const bf16_t *A, *Bt, *A2, *Bt2; int lda, ldb;
    int nMf, nN, nfull, G, c, nseg, ntf, nsub, nslice, nts, pm_sub0, nf_c, sub_first = 0, w0 = 0;
    __device__ void init(const bf16_t* A_, const bf16_t* Bt_, const bf16_t* A2_, const bf16_t* Bt2_, int lda_, int ldb_, int Mfull, int N_, int Kseg, int nseg_, int G_, int c_, int Msub, int nslice_, int pm_sub0_) {
        A = A_; Bt = Bt_; A2 = A2_; Bt2 = Bt2_; lda = lda_; ldb = ldb_; nMf = Mfull / BM; nN = N_ / BM; nfull = nMf * nN; G = G_; c = c_; nseg = nseg_; ntf = Kseg / BK;
        nslice = nslice_; nsub = (Msub / BM) * nN * nslice_; nts = nslice_ ? (Kseg * nseg_ / nslice_) / BK : 0; pm_sub0 = pm_sub0_;
        nf_c = (c < nfull) ? (nfull - c + G - 1) / G : 0;
    }
    __device__ void set_range(int w0_, int w1_) { w0 = w0_; const int cnt = w1_ - w0_; nf_c = (c >= 0 && c < cnt) ? (cnt - c + G - 1) / G : 0; }
    __device__ bool next(int i_, Unit& u) const {
        int i = i_; const size_t tA = (size_t)BM * lda * 2, tB = (size_t)BM * ldb * 2;
        const int ns_c = (c < nsub) ? (nsub - c + G - 1) / G : 0;
        if (sub_first) { if (i_ < ns_c) i = nf_c * nseg + i_; else { i = i_ - ns_c; if (i >= nf_c * nseg) return false; } }
        if (i < nf_c * nseg) {
            const int r = (nseg == 2) ? (i >> 1) : i; u.seg = (nseg == 2) ? (i & 1) : 0; u.kind = 0; u.ks = 0; u.nt = ntf;
            int wgid = w0 + r * G + c; { const int q = nfull / NXCD, rr = nfull % NXCD, xcd = wgid % NXCD, off = wgid / NXCD; wgid = (xcd < rr ? xcd * (q + 1) : rr * (q + 1) + (xcd - rr) * q) + off; }
            const int nig = WGM * nN, gid = wgid / nig, fm = gid * WGM, gsz = (nMf - fm) < WGM ? (nMf - fm) : WGM;
            u.pm = fm + ((wgid % nig) % gsz); u.pn = (wgid % nig) / gsz;
            u.a = (const char*)(u.seg ? A2 : A) + (size_t)u.pm * tA; u.b = (const char*)(u.seg ? Bt2 : Bt) + (size_t)u.pn * tB; return true;
        }
        const long sidx = (long)(nf_c + (i - nf_c * nseg)) * G + c - nfull;
        if (sidx < 0 || sidx >= nsub) return false;
        const int s = (int)sidx, ks = s % nslice, tile = s / nslice, sps = nslice / nseg;
        u.kind = 1; u.ks = ks; u.nt = nts; u.pn = tile % nN; u.pm = pm_sub0 + tile / nN; u.seg = ks / sps;
        const size_t kofs = (size_t)(ks % sps) * nts * BK * 2;
        u.a = (const char*)(u.seg ? A2 : A) + (size_t)u.pm * tA + kofs; u.b = (const char*)(u.seg ? Bt2 : Bt) + (size_t)u.pn * tB + kofs; return true;
    }
};

template <class Epi, bool ALIGN_EPI = true>
__device__ __forceinline__ void gemm_phase(PG8_LAS unsigned char* lds, const Order& S, const Epi& E) {
    const int tid = threadIdx.x, wid = __builtin_amdgcn_readfirstlane(tid >> 6), lane = tid & 63, wr = wid >> 2, wc = wid & 3, fr = lane & 15, fq = lane >> 4;
    unsigned voffA[2], voffB[2];
#pragma unroll
    for (int i = 0; i < 2; ++i) { int R, C; stage_rc(tid * 16 + i * 8192, R, C); const int Rb = Epi::PERM ? ((R & ~31) + perm32(R & 31)) : R;
        voffA[i] = (unsigned)(R * S.lda + C) * 2u; voffB[i] = (unsigned)(Rb * S.ldb + C) * 2u; }
    const size_t kstep = (size_t)(BK * 2);
    const size_t hstepA = (size_t)HALF * S.lda * 2, hstepB = (size_t)HALF * S.ldb * 2;
    const unsigned ldsw = (unsigned)wid * 1024u;
    const int aoff = lds_byte(wr * 64 + fr, fq * 8), boff = lds_byte(wc * 32 + fr, fq * 8);
#define PG8_SA(b, h) (((b) * 2 + (h)) * HTB)
#define PG8_SB(b, h) ((4 + (b) * 2 + (h)) * HTB)
#define PG8_STAGE(bufoff, gbase, voff) do { _Pragma("unroll") for (int _i = 0; _i < 2; ++_i) \
        __builtin_amdgcn_global_load_lds((const unsigned*)((const char*)(gbase) + (voff)[_i]), (PG8_LAS unsigned*)(lds + (bufoff) + ldsw + _i * 8192), 16, 0, 0); } while (0)
#define PG8_LDA(dst, b, h) do { _Pragma("unroll") for (int m = 0; m < 4; ++m) _Pragma("unroll") for (int k = 0; k < 2; ++k) dst[m][k] = *(const PG8_LAS bf16x8*)(lds + PG8_SA(b, h) + aoff + m * 2048 + k * 1024); } while (0)
#define PG8_LDB(dst, b, h) do { _Pragma("unroll") for (int n = 0; n < 2; ++n) _Pragma("unroll") for (int k = 0; k < 2; ++k) dst[n][k] = *(const PG8_LAS bf16x8*)(lds + PG8_SB(b, h) + boff + n * 2048 + k * 1024); } while (0)
#define PG8_MMA(ai, bj, At, Bt) do { __builtin_amdgcn_sched_barrier(0); __builtin_amdgcn_s_setprio(1); _Pragma("unroll") for (int m = 0; m < 4; ++m) _Pragma("unroll") for (int n = 0; n < 2; ++n) _Pragma("unroll") for (int k = 0; k < 2; ++k) \
        acc[ai][bj][m][n] = __builtin_amdgcn_mfma_f32_16x16x32_bf16(Bt[n][k], At[m][k], acc[ai][bj][m][n], 0, 0, 0); __builtin_amdgcn_s_setprio(0); __builtin_amdgcn_sched_barrier(0); } while (0)
#define PG8_WAIT_V(n) asm volatile("s_waitcnt vmcnt(" #n ")" ::: "memory")
#define PG8_WAIT_L(n) asm volatile("s_waitcnt lgkmcnt(" #n ")" ::: "memory")
#define PG8_BAR __builtin_amdgcn_s_barrier()
#define PG8_SCHED __builtin_amdgcn_sched_barrier(0)
    Unit cur, nxt; int ui = 0;
    if (!S.next(0, cur)) return;
    f32x4 acc[2][2][4][2];
#pragma unroll
    for (int a = 0; a < 2; ++a)
#pragma unroll
        for (int b = 0; b < 2; ++b)
#pragma unroll
            for (int m = 0; m < 4; ++m)
#pragma unroll
                for (int n = 0; n < 2; ++n) acc[a][b][m][n] = (f32x4){0.f, 0.f, 0.f, 0.f};
    bf16x8 At[4][2], B0[2][2], B1[2][2];
    const char* cA = cur.a; const char* cB = cur.b;
    PG8_STAGE(PG8_SB(0, 0), cB, voffB); PG8_STAGE(PG8_SB(0, 1), cB + hstepB, voffB); PG8_STAGE(PG8_SA(0, 0), cA, voffA); PG8_STAGE(PG8_SA(0, 1), cA + hstepA, voffA);
    if (wr == 1) PG8_BAR;
    PG8_WAIT_V(2); PG8_BAR;
    PG8_STAGE(PG8_SB(1, 0), cB + kstep, voffB); PG8_STAGE(PG8_SA(1, 0), cA + kstep, voffA); PG8_STAGE(PG8_SB(1, 1), cB + hstepB + kstep, voffB);
    PG8_WAIT_V(6); PG8_BAR;
    for (;;) {
        const bool has_next = S.next(ui + 1, nxt);
        const char* nA = has_next ? nxt.a : cA; const char* nB = has_next ? nxt.b : cB;
        const int nt = cur.nt;
        for (int t = 0; t < nt; t += 2) {
            const bool last = (t == nt - 2);
            const char* a1 = cA + (size_t)(t + 1) * kstep;
            const char* a2 = last ? nA : cA + (size_t)(t + 2) * kstep; const char* b2 = last ? nB : cB + (size_t)(t + 2) * kstep;
            const char* a3 = a2 + kstep; const char* b3 = b2 + kstep;
            PG8_LDB(B0, 0, 0); PG8_LDB(B1, 0, 1); PG8_SCHED; PG8_LDA(At, 0, 0); PG8_STAGE(PG8_SA(1, 1), a1 + hstepA, voffA);
            PG8_WAIT_V(8); PG8_WAIT_L(0); PG8_BAR; PG8_MMA(0, 0, At, B0); PG8_MMA(0, 1, At, B1); PG8_BAR; PG8_SCHED;
            PG8_LDA(At, 0, 1); PG8_STAGE(PG8_SB(0, 0), b2, voffB); PG8_STAGE(PG8_SB(0, 1), b2 + hstepB, voffB); PG8_STAGE(PG8_SA(0, 0), a2, voffA);
            PG8_WAIT_V(8); PG8_WAIT_L(0); PG8_BAR; PG8_MMA(1, 0, At, B0); PG8_MMA(1, 1, At, B1); PG8_BAR; PG8_SCHED;
            PG8_LDB(B0, 1, 0); PG8_LDB(B1, 1, 1); PG8_SCHED; PG8_LDA(At, 1, 0); PG8_STAGE(PG8_SA(0, 1), a2 + hstepA, voffA);
            PG8_WAIT_V(8); PG8_WAIT_L(0); PG8_BAR; PG8_MMA(0, 0, At, B0); PG8_MMA(0, 1, At, B1); PG8_BAR; PG8_SCHED;
            PG8_LDA(At, 1, 1); PG8_STAGE(PG8_SB(1, 0), b3, voffB); PG8_STAGE(PG8_SB(1, 1), b3 + hstepB, voffB); PG8_STAGE(PG8_SA(1, 0), a3, voffA);
            PG8_WAIT_V(8); PG8_WAIT_L(0); PG8_BAR; PG8_MMA(1, 0, At, B0); PG8_MMA(1, 1, At, B1); PG8_BAR; PG8_SCHED;
        }
        if (ALIGN_EPI) { if (wr == 0) PG8_BAR; }
        E(acc, cur, wr, wc, fr, fq);
        if (!has_next) break;
        if (!(Epi::TWOSEG && nxt.seg == 1)) {
#pragma unroll
        for (int a = 0; a < 2; ++a)
#pragma unroll
            for (int b = 0; b < 2; ++b)
#pragma unroll
                for (int m = 0; m < 4; ++m)
#pragma unroll
                    for (int n = 0; n < 2; ++n) acc[a][b][m][n] = (f32x4){0.f, 0.f, 0.f, 0.f};
        }
        cur = nxt; cA = nA; cB = nB; ++ui;
        if (ALIGN_EPI) { if (wr == 1) PG8_BAR; }
    }
    PG8_WAIT_V(0);
    if (!ALIGN_EPI) { if (wr == 0) PG8_BAR; }
    PG8_BAR;
#undef PG8_SA
#undef PG8_SB
#undef PG8_STAGE
#undef PG8_LDA
#undef PG8_LDB
#undef PG8_MMA
#undef PG8_WAIT_V
#undef PG8_WAIT_L
#undef PG8_BAR
#undef PG8_SCHED
}

template <bool PERM_>
__device__ __forceinline__ void slab_store(const f32x4 (&acc)[2][2][4][2], const Unit& u, int wr, int wc, int fr, int fq, bf16_t* slab, int pm_sub0, const bf16_t* Gt, const bf16_t* Gt2 = nullptr) {
    const int rloc = (u.pm - pm_sub0) * BM + wr * 64 + fr, grow = u.pm * BM + wr * 64 + fr;
    bf16_t* sb = slab + (size_t)u.ks * (512 * DM);
#pragma unroll
    for (int ai = 0; ai < 2; ++ai)
#pragma unroll
        for (int m = 0; m < 4; ++m) {
#pragma unroll
            for (int bj = 0; bj < 2; ++bj) {
                if (PERM_) { const int col = u.pn * BM + bj * HALF + wc * 32 + 8 * fq; f32x4 v0 = acc[ai][bj][m][0], v1 = acc[ai][bj][m][1];
                    if (Gt) { const v4u b = *(const v4u*)(Gt + (size_t)(grow + ai * HALF + m * 16) * DM + col); v0 *= (f32x4){bf_lo(b.x), bf_hi(b.x), bf_lo(b.y), bf_hi(b.y)}; v1 *= (f32x4){bf_lo(b.z), bf_hi(b.z), bf_lo(b.w), bf_hi(b.w)}; }
                    if (Gt2) { const v4u b = *(const v4u*)(Gt2 + (size_t)(grow + ai * HALF + m * 16) * DM + col); v0 *= (f32x4){bf_lo(b.x), bf_hi(b.x), bf_lo(b.y), bf_hi(b.y)}; v1 *= (f32x4){bf_lo(b.z), bf_hi(b.z), bf_lo(b.w), bf_hi(b.w)}; }
                    v4u w; w.x = cvt_pk_bf16(v0[0], v0[1]); w.y = cvt_pk_bf16(v0[2], v0[3]); w.z = cvt_pk_bf16(v1[0], v1[1]); w.w = cvt_pk_bf16(v1[2], v1[3]);
                    *(v4u*)(sb + (size_t)(rloc + ai * HALF + m * 16) * DM + col) = w; }
                else {
#pragma unroll
                    for (int n = 0; n < 2; ++n) { const int col = u.pn * BM + bj * HALF + wc * 32 + 16 * n + 4 * fq; const f32x4 v = acc[ai][bj][m][n];
                        v2u w; w.x = cvt_pk_bf16(v[0], v[1]); w.y = cvt_pk_bf16(v[2], v[3]); *(v2u*)(sb + (size_t)(rloc + ai * HALF + m * 16) * DM + col) = w; } }
            }
            asm volatile("" ::: "memory"); }
}
struct EpiStore {
    static constexpr bool PERM = true, TWOSEG = false;
    bf16_t* O; int ldc; bf16_t* slab; int pm_sub0;
    __device__ __forceinline__ void operator()(f32x4 (&acc)[2][2][4][2], const Unit& u, int wr, int wc, int fr, int fq) const {
        if (u.kind == 1) { slab_store<true>(acc, u, wr, wc, fr, fq, slab, pm_sub0, nullptr); return; }
        const int row0 = u.pm * BM + wr * 64 + fr, col0 = u.pn * BM + wc * 32 + 8 * fq;
#pragma unroll
        for (int ai = 0; ai < 2; ++ai)
#pragma unroll
            for (int m = 0; m < 4; ++m) { bf16_t* rowp = O + (size_t)(row0 + ai * HALF + m * 16) * ldc + col0;
#pragma unroll
                for (int bj = 0; bj < 2; ++bj) { const f32x4 v0 = acc[ai][bj][m][0], v1 = acc[ai][bj][m][1];
                    v4u w; w.x = cvt_pk_bf16(v0[0], v0[1]); w.y = cvt_pk_bf16(v0[2], v0[3]); w.z = cvt_pk_bf16(v1[0], v1[1]); w.w = cvt_pk_bf16(v1[2], v1[3]);
                    *(v4u*)(rowp + bj * HALF) = w; } }
    }
};
struct EpiIn {
    static constexpr bool PERM = true, TWOSEG = false;
    bf16_t* seg0; float* out; int pmo;
    template <int ACT, bool F32OUT>
    __device__ __forceinline__ void run(const f32x4 (&acc)[2][2][4][2], bf16_t* O, int ldc, int row0, int col0, float* fo) const {
#pragma unroll
        for (int ai = 0; ai < 2; ++ai)
#pragma unroll
            for (int m = 0; m < 4; ++m) { bf16_t* rowp = O + (size_t)(row0 + ai * HALF + m * 16) * ldc + col0;
#pragma unroll
                for (int bj = 0; bj < 2; ++bj) { f32x4 v0 = acc[ai][bj][m][0], v1 = acc[ai][bj][m][1];
                    if (F32OUT) { float* fp = fo + (size_t)(ai * HALF + m * 16) * DBR + bj * HALF; *(f32x4*)fp = v0; *(f32x4*)(fp + 4) = v1; }
                    if (ACT == 1) { f32x2 a = gelu_pk((f32x2){v0[0], v0[1]}), b = gelu_pk((f32x2){v0[2], v0[3]}), c = gelu_pk((f32x2){v1[0], v1[1]}), d = gelu_pk((f32x2){v1[2], v1[3]});
                        v0 = (f32x4){a.x, a.y, b.x, b.y}; v1 = (f32x4){c.x, c.y, d.x, d.y}; }
                    if (ACT == 2) {
#pragma unroll
                        for (int j = 0; j < 4; ++j) { v0[j] = silu_f(v0[j]); v1[j] = silu_f(v1[j]); } }
                    if (ACT == 3) {
#pragma unroll
                        for (int j = 0; j < 4; ++j) { v0[j] = sigmoid_f(v0[j]); v1[j] = sigmoid_f(v1[j]); } }
                    v4u w; w.x = cvt_pk_bf16(v0[0], v0[1]); w.y = cvt_pk_bf16(v0[2], v0[3]); w.z = cvt_pk_bf16(v1[0], v1[1]); w.w = cvt_pk_bf16(v1[2], v1[3]);
                    *(v4u*)(rowp + bj * HALF) = w; } }
    }
    template <int KIND  >
    __device__ __forceinline__ void run_pair(const f32x4 (&acc)[2][2][4][2], bf16_t* O1, bf16_t* O2, int ldc, int row0, int ch0) const {
        const int od = (threadIdx.x >> 4) & 1;
#define RP_STORE(O_, W_) do { const v2u send_ = od ? W_[0] : W_[1], mine_ = od ? W_[1] : W_[0]; v2u rc_; rc_.x = (unsigned)__shfl_xor((int)send_.x, 16); rc_.y = (unsigned)__shfl_xor((int)send_.y, 16); \
            const v4u out_ = od ? (v4u){rc_.x, rc_.y, mine_.x, mine_.y} : (v4u){mine_.x, mine_.y, rc_.x, rc_.y}; *(v4u*)((O_) + rp) = out_; } while (0)
#pragma unroll
        for (int ai = 0; ai < 2; ++ai)
#pragma unroll
            for (int m = 0; m < 4; ++m) { const size_t rp = (size_t)(row0 + ai * HALF + m * 16) * ldc + ch0 - 4 * od + od * (HALF / 2);
                v2u wA[2], wB[2];
#pragma unroll
                for (int bj = 0; bj < 2; ++bj) { const f32x4 v0 = acc[ai][bj][m][0], v1 = acc[ai][bj][m][1];
                    if (KIND == 0) { const f32x2 a = gelu_pk((f32x2){v0[0], v0[1]}), b = gelu_pk((f32x2){v0[2], v0[3]});
                        wA[bj].x = cvt_pk_bf16(a.x * silu_f(v1[0]), a.y * silu_f(v1[1])); wA[bj].y = cvt_pk_bf16(b.x * silu_f(v1[2]), b.y * silu_f(v1[3])); }
                    else { float r[4], sb[4];
#pragma unroll
                        for (int j = 0; j < 4; ++j) { const float ea = __builtin_amdgcn_exp2f(-1.4426950408889634f * v0[j]), eb = __builtin_amdgcn_exp2f(-1.4426950408889634f * v1[j]);
                            sb[j] = __builtin_amdgcn_rcpf(1.0f + eb); r[j] = (1.0f + eb) * __builtin_amdgcn_rcpf(1.0f + ea); }
                        wA[bj].x = cvt_pk_bf16(r[0], r[1]); wA[bj].y = cvt_pk_bf16(r[2], r[3]); wB[bj].x = cvt_pk_bf16(sb[0], sb[1]); wB[bj].y = cvt_pk_bf16(sb[2], sb[3]); } }
                RP_STORE(O1, wA);
                if (KIND == 1) RP_STORE(O2, wB); }
#undef RP_STORE
    }
    __device__ __forceinline__ void operator()(f32x4 (&acc)[2][2][4][2], const Unit& u, int wr, int wc, int fr, int fq) const {
        const int pn = u.pn, pm = u.pm + pmo, rloc = wr * 64 + fr, row0 = pm * BM + rloc;
        if (pn >= 56) { const int ch0 = (pn - 56) * HALF + wc * 16 + 4 * fq;
            run_pair<1>(acc, seg0 + (size_t)7 * M * DBR, seg0 + (size_t)7 * M * DBR + (size_t)M * DM, DM, row0, ch0); return; }
        if (pn < 16) { run_pair<0>(acc, seg0, nullptr, DBR, row0, pn * HALF + wc * 16 + 4 * fq); return; }
        if (pn < 24) { run<1, false>(acc, seg0 + (size_t)M * DBR, DBR, row0, (pn - 16) * BM + wc * 32 + 8 * fq, nullptr); return; }
        const int s = pn >> 3, col0 = (pn & 7) * BM + wc * 32 + 8 * fq; bf16_t* O = seg0 + (size_t)s * M * DBR;
        if (s == 6) { run<2, false>(acc, O, DBR, row0, col0, nullptr); return; }
        if (s == 3) { run<0, false>(acc, O, DBR, row0, col0, nullptr); return; }
        float* fo = nullptr;
        if (pm >= 64) fo = out + (s == 4 ? OFF_KS : OFF_VS) + (size_t)((pm - 64) * BM + rloc) * DBR + col0;
        else if ((pm & 7) >= 6) fo = out + (s == 4 ? OFF_KP : OFF_VP) + (size_t)((pm >> 3) * 512 + ((pm & 7) - 6) * BM + rloc) * DBR + col0;
        if (fo) run<0, true>(acc, O, DBR, row0, col0, fo); else run<0, false>(acc, O, DBR, row0, col0, nullptr);
    }
};
struct EpiMerge {
    static constexpr bool PERM = true, TWOSEG = true;
    const bf16_t* SGA; const bf16_t* SGB; bf16_t* O;
    __device__ __forceinline__ void operator()(f32x4 (&acc)[2][2][4][2], const Unit& u, int wr, int wc, int fr, int fq) const {
        const int row0 = u.pm * BM + wr * 64 + fr, col0 = u.pn * BM + wc * 32 + 8 * fq;
#define MG_OFF(it) ((size_t)(row0 + ((it) >> 2) * HALF + ((it) & 3) * 16) * DM + col0)
        if (u.seg == 0) {
            v4u ga[2][2];
            { const size_t off = MG_OFF(0); ga[0][0] = *(const v4u*)(SGA + off); ga[0][1] = *(const v4u*)(SGA + off + HALF); }
#pragma unroll
            for (int it = 0; it < 8; ++it) { const int ai = it >> 2, m = it & 3, cb = it & 1, nb = cb ^ 1;
                if (it + 1 < 8) { const size_t off = MG_OFF(it + 1); ga[nb][0] = *(const v4u*)(SGA + off); ga[nb][1] = *(const v4u*)(SGA + off + HALF); }
                asm volatile("" ::: "memory");
#pragma unroll
                for (int bj = 0; bj < 2; ++bj) { const v4u a = ga[cb][bj];
                    acc[ai][bj][m][0] *= (f32x4){bf_lo(a.x), bf_hi(a.x), bf_lo(a.y), bf_hi(a.y)}; acc[ai][bj][m][1] *= (f32x4){bf_lo(a.z), bf_hi(a.z), bf_lo(a.w), bf_hi(a.w)}; }
                asm volatile("" ::: "memory"); }
        } else {
            v4u gb[2][2];
            { const size_t off = MG_OFF(0); gb[0][0] = *(const v4u*)(SGB + off); gb[0][1] = *(const v4u*)(SGB + off + HALF); }
#pragma unroll
            for (int it = 0; it < 8; ++it) { const int ai = it >> 2, m = it & 3, cb = it & 1, nb = cb ^ 1;
                if (it + 1 < 8) { const size_t off = MG_OFF(it + 1); gb[nb][0] = *(const v4u*)(SGB + off); gb[nb][1] = *(const v4u*)(SGB + off + HALF); }
                asm volatile("" ::: "memory");
                const size_t off = MG_OFF(it);
#pragma unroll
                for (int bj = 0; bj < 2; ++bj) { const v4u b = gb[cb][bj];
                    const f32x4 v0 = acc[ai][bj][m][0] * (f32x4){bf_lo(b.x), bf_hi(b.x), bf_lo(b.y), bf_hi(b.y)}, v1 = acc[ai][bj][m][1] * (f32x4){bf_lo(b.z), bf_hi(b.z), bf_lo(b.w), bf_hi(b.w)};
                    v4u w; w.x = cvt_pk_bf16(v0[0], v0[1]); w.y = cvt_pk_bf16(v0[2], v0[3]); w.z = cvt_pk_bf16(v1[0], v1[1]); w.w = cvt_pk_bf16(v1[2], v1[3]);
                    *(v4u*)(O + off + bj * HALF) = w; }
                asm volatile("" ::: "memory"); }
        }
#undef MG_OFF
    }
};
struct EpiMergeSub {
    static constexpr bool PERM = true, TWOSEG = false;
    const bf16_t* SGA; const bf16_t* SGB; bf16_t* slab; int pm_sub0;
    __device__ __forceinline__ void operator()(f32x4 (&acc)[2][2][4][2], const Unit& u, int wr, int wc, int fr, int fq) const {
        slab_store<true>(acc, u, wr, wc, fr, fq, slab, pm_sub0, SGB, u.seg ? nullptr : SGA);
    }
};
struct EpiFinal {
    static constexpr bool PERM = true, TWOSEG = false;
    float* Y; const bf16_t* P; bf16_t* slab; int pm_sub0; const bf16_t* XB;
    __device__ __forceinline__ void operator()(f32x4 (&acc)[2][2][4][2], const Unit& u, int wr, int wc, int fr, int fq) const {
        if (u.kind == 1) { slab_store<true>(acc, u, wr, wc, fr, fq, slab, pm_sub0, nullptr); return; }
        const int row0 = u.pm * BM + wr * 64 + fr, col0 = u.pn * BM + wc * 32 + 8 * fq;
#define FN_OFF(it) ((size_t)(row0 + ((it) >> 2) * HALF + ((it) & 3) * 16) * DM + col0)
        v4u xv[2][2], pv[2][2];
        { const size_t off = FN_OFF(0);
#pragma unroll
          for (int bj = 0; bj < 2; ++bj) { xv[0][bj] = *(const v4u*)(XB + off + bj * HALF); pv[0][bj] = *(const v4u*)(P + off + bj * HALF); } }
#pragma unroll
        for (int it = 0; it < 8; ++it) { const int ai = it >> 2, m = it & 3, cb = it & 1, nb = cb ^ 1;
            if (it + 1 < 8) { const size_t off = FN_OFF(it + 1);
#pragma unroll
                for (int bj = 0; bj < 2; ++bj) { xv[nb][bj] = *(const v4u*)(XB + off + bj * HALF); pv[nb][bj] = *(const v4u*)(P + off + bj * HALF); } }
            asm volatile("" ::: "memory");
            const size_t off = FN_OFF(it);
#pragma unroll
            for (int bj = 0; bj < 2; ++bj) { const v4u x1 = xv[cb][bj], p = pv[cb][bj]; const f32x4 a0 = acc[ai][bj][m][0], a1 = acc[ai][bj][m][1];
                f32x4 y0, y1;
                y0[0] = bf_lo(x1.x) + sigmoid_f(a0[0]) * bf_lo(p.x); y0[1] = bf_hi(x1.x) + sigmoid_f(a0[1]) * bf_hi(p.x); y0[2] = bf_lo(x1.y) + sigmoid_f(a0[2]) * bf_lo(p.y); y0[3] = bf_hi(x1.y) + sigmoid_f(a0[3]) * bf_hi(p.y);
                y1[0] = bf_lo(x1.z) + sigmoid_f(a1[0]) * bf_lo(p.z); y1[1] = bf_hi(x1.z) + sigmoid_f(a1[1]) * bf_hi(p.z); y1[2] = bf_lo(x1.w) + sigmoid_f(a1[2]) * bf_lo(p.w); y1[3] = bf_hi(x1.w) + sigmoid_f(a1[3]) * bf_hi(p.w);
                *(f32x4*)(Y + off + bj * HALF) = y0; *(f32x4*)(Y + off + bj * HALF + 4) = y1; }
            asm volatile("" ::: "memory"); }
#undef FN_OFF
    }
};
}

namespace att {
constexpr float SCALE = 0.08838834764831845f, THR = 8.f;
constexpr int SHM = 16384;
constexpr int OFF_V = 0, OFF_K = 4 * SHM, OFF_TAB = 6 * SHM, OFF_WS = 6 * SHM + 2048, LDS_NEED = OFF_WS + 8 * 256;
#define KSWZ(row, colB) ((row) * 256 + ((colB) ^ (((row) & 7) << 4)))
#define SBAR() __builtin_amdgcn_sched_barrier(0)
__device__ __forceinline__ int v_st(int k, int c) { const int kk = (k & ~0xC) | ((k & 4) << 1) | ((k & 8) >> 1); return ((kk >> 3) * 4 + (c >> 5)) * 512 + ((kk & 7) * 32 + (c & 31)) * 2; }
__device__ __forceinline__ int v_rd_base(int lane) { return ((lane & 3) << 3) | (((lane >> 2) & 3) << 6) | (((lane >> 4) & 1) << 5) | (((lane >> 5) & 1) << 8); }
constexpr int v_rd_off(int d0, int ks, int half) { return d0 * 512 + ks * 4096 + half * 2048; }
__device__ __forceinline__ int crow(int r, int hi) { return (r & 3) + 8 * (r >> 2) + 4 * hi; }
__device__ __forceinline__ void partialSM(f32x16& p0, f32x16& p1, float& m_reg, float& mn, float& alpha) {
    float pmax = p0[0];
#pragma unroll
    for (int r = 1; r < 16; ++r) pmax = fmaxf(pmax, p0[r]);
#pragma unroll
    for (int r = 0; r < 16; ++r) pmax = fmaxf(pmax, p1[r]);
    { auto rr = __builtin_amdgcn_permlane32_swap(__float_as_uint(pmax), __float_as_uint(pmax), false, false);
      pmax = fmaxf(__uint_as_float(rr[0]), __uint_as_float(rr[1])); }
    constexpr float C2 = 1.4426950408889634f * SCALE;
    if (__builtin_expect(__all((pmax - m_reg) * SCALE <= THR), 1)) { mn = m_reg; alpha = 1.f; }
    else { mn = fmaxf(m_reg, pmax); alpha = __builtin_amdgcn_exp2f((m_reg - mn) * C2); m_reg = mn; }
    const float mnL = -mn * C2;
#pragma unroll
    for (int r = 0; r < 16; ++r) p0[r] = fmaf(p0[r], C2, mnL);
#pragma unroll
    for (int r = 0; r < 16; ++r) p1[r] = fmaf(p1[r], C2, mnL);
#pragma unroll
    for (int r = 0; r < 16; ++r) p0[r] = __builtin_amdgcn_exp2f(p0[r]);
}
__device__ __forceinline__ void finishSM(f32x16& p0, f32x16& p1, float alpha, float& l_reg, bf16x8& pa0, bf16x8& pa1, bf16x8& pa2, bf16x8& pa3) {
#pragma unroll
    for (int r = 0; r < 16; ++r) p1[r] = __builtin_amdgcn_exp2f(p1[r]);
    float ps = 0;
#pragma unroll
    for (int r = 0; r < 16; ++r) ps += p0[r];
#pragma unroll
    for (int r = 0; r < 16; ++r) ps += p1[r];
    { auto rr = __builtin_amdgcn_permlane32_swap(__float_as_uint(ps), __float_as_uint(ps), false, false);
      ps = __uint_as_float(rr[0]) + __uint_as_float(rr[1]); }
    l_reg = l_reg * alpha + ps;
#define PK4(P, B_, OUT) do { unsigned a0 = cvt_pk_bf16(P[B_+0], P[B_+1]), a1 = cvt_pk_bf16(P[B_+2], P[B_+3]);                          \
        unsigned b0 = cvt_pk_bf16(P[B_+4], P[B_+5]), b1 = cvt_pk_bf16(P[B_+6], P[B_+7]);                                             \
        auto r0 = __builtin_amdgcn_permlane32_swap(a0, b0, false, false); auto r1 = __builtin_amdgcn_permlane32_swap(a1, b1, false, false); \
        v4u w = {r0[0], r1[0], r0[1], r1[1]}; OUT = *reinterpret_cast<bf16x8*>(&w); } while (0)
    PK4(p0, 0, pa0); PK4(p0, 8, pa1); PK4(p1, 0, pa2); PK4(p1, 8, pa3);
#undef PK4
}
template <int KB>
__device__ __forceinline__ void qkt(f32x16& p0, f32x16& p1, const char* K_lds, int r32, int hi, const bf16x8* qr) {
    const char* kb[4];
#pragma unroll
    for (int dd = 0; dd < 4; ++dd) kb[dd] = K_lds + KB * SHM + KSWZ(r32, (dd * 16 + hi * 8) * 2);
#pragma unroll
    for (int q4 = 0; q4 < 4; ++q4) {
        bf16x8 f0[2], f1[2];
#pragma unroll
        for (int d2 = 0; d2 < 2; ++d2) { const int dd = (q4 & 1) * 2 + d2; const char* a = kb[dd] + (q4 >> 1) * 128; f0[d2] = *reinterpret_cast<const bf16x8*>(a); f1[d2] = *reinterpret_cast<const bf16x8*>(a + 32 * 256); }
        asm volatile("s_waitcnt lgkmcnt(0)" ::: "memory"); SBAR();
#pragma unroll
        for (int d2 = 0; d2 < 2; ++d2) { const int dd = (q4 & 1) * 2 + d2; p0 = __builtin_amdgcn_mfma_f32_32x32x16_bf16(f0[d2], qr[(q4 >> 1) * 4 + dd], p0, 0, 0, 0); p1 = __builtin_amdgcn_mfma_f32_32x32x16_bf16(f1[d2], qr[(q4 >> 1) * 4 + dd], p1, 0, 0, 0); }
    }
}
typedef short s16x8 __attribute__((ext_vector_type(8)));
__device__ __forceinline__ s16x4 trrd(int addr) { return __builtin_amdgcn_ds_read_tr16_b64_v4i16((LAS s16x4*)(unsigned long)(unsigned)addr); }
__device__ __forceinline__ bf16x8 trcat(s16x4 l, s16x4 h) { return __builtin_bit_cast(bf16x8, (s16x8)__builtin_shufflevector(l, h, 0, 1, 2, 3, 4, 5, 6, 7)); }
template <int VB>
__device__ __forceinline__ void pv_tile(f32x16* o, int vb0, bf16x8 pa0, bf16x8 pa1, bf16x8 pa2, bf16x8 pa3) {
#define PV_KS(ks, PA) do { constexpr int b_ = VB * SHM + v_rd_off(0, ks, 0); \
        const s16x4 l0 = trrd(vb0 + b_), h0 = trrd(vb0 + b_ + 2048), l1 = trrd(vb0 + b_ + 512), h1 = trrd(vb0 + b_ + 512 + 2048), l2 = trrd(vb0 + b_ + 1024), h2 = trrd(vb0 + b_ + 1024 + 2048), l3 = trrd(vb0 + b_ + 1536), h3 = trrd(vb0 + b_ + 1536 + 2048); \
        SBAR();   \
        o[0] = __builtin_amdgcn_mfma_f32_32x32x16_bf16(PA, trcat(l0, h0), o[0], 0, 0, 0);   \
        o[1] = __builtin_amdgcn_mfma_f32_32x32x16_bf16(PA, trcat(l1, h1), o[1], 0, 0, 0);   \
        o[2] = __builtin_amdgcn_mfma_f32_32x32x16_bf16(PA, trcat(l2, h2), o[2], 0, 0, 0);   \
        o[3] = __builtin_amdgcn_mfma_f32_32x32x16_bf16(PA, trcat(l3, h3), o[3], 0, 0, 0); } while (0)
    PV_KS(0, pa0); PV_KS(1, pa1); PV_KS(2, pa2); PV_KS(3, pa3);
#undef PV_KS
}

__device__ __forceinline__ void step_uni(const bool act, f32x16* o, f32x16& p0, f32x16& p1, int vb, float& m_reg, float& l_reg, float& alpha, bf16x8& pa0, bf16x8& pa1, bf16x8& pa2, bf16x8& pa3) {
    s16x4 l0, l1, h0, h1;
#define PV_RD(ks) do { constexpr int b_ = v_rd_off(0, ks, 0); SBAR(); l0 = trrd(vb + b_); h0 = trrd(vb + b_ + 2048); l1 = trrd(vb + b_ + 512); h1 = trrd(vb + b_ + 512 + 2048); SBAR(); } while (0)
#define PV_RD2(ks) do { constexpr int b_ = v_rd_off(0, ks, 0); SBAR(); l0 = trrd(vb + b_ + 1024); h0 = trrd(vb + b_ + 1024 + 2048); l1 = trrd(vb + b_ + 1536); h1 = trrd(vb + b_ + 1536 + 2048); SBAR(); } while (0)
#define PV_M(i, PA, L, H) do { SBAR(); o[i] = __builtin_amdgcn_mfma_f32_32x32x16_bf16(PA, trcat(L, H), o[i], 0, 0, 0); SBAR(); } while (0)
    constexpr float C2 = 1.4426950408889634f * SCALE;
    float pmax = 0.f, mnL = 0.f, ps = 0.f;
    PV_RD(0);
    if (act) { pmax = p0[0];
#pragma unroll
        for (int r = 1; r < 16; ++r) pmax = fmaxf(pmax, p0[r]); }
    PV_M(0, pa0, l0, h0);
    if (act) {
#pragma unroll
        for (int r = 0; r < 8; ++r) pmax = fmaxf(pmax, p1[r]); }
    PV_M(1, pa0, l1, h1);
    PV_RD2(0);
    if (act) {
#pragma unroll
        for (int r = 8; r < 16; ++r) pmax = fmaxf(pmax, p1[r]);
        auto rr = __builtin_amdgcn_permlane32_swap(__float_as_uint(pmax), __float_as_uint(pmax), false, false);
        pmax = fmaxf(__uint_as_float(rr[0]), __uint_as_float(rr[1])); }
    PV_M(2, pa0, l0, h0);
    if (act) { float mn;
        if (__builtin_expect(__all((pmax - m_reg) * SCALE <= THR), 1)) { mn = m_reg; alpha = 1.f; }
        else { mn = fmaxf(m_reg, pmax); alpha = __builtin_amdgcn_exp2f((m_reg - mn) * C2); m_reg = mn; }
        mnL = -mn * C2; }
    PV_M(3, pa0, l1, h1);
    PV_RD(1);
    if (act) {
#pragma unroll
        for (int r = 0; r < 16; ++r) p0[r] = fmaf(p0[r], C2, mnL); }
    PV_M(0, pa1, l0, h0);
    if (act) {
#pragma unroll
        for (int r = 0; r < 16; ++r) p1[r] = fmaf(p1[r], C2, mnL); }
    PV_M(1, pa1, l1, h1);
    PV_RD2(1);
    if (act) {
#pragma unroll
        for (int r = 0; r < 4; ++r) p0[r] = __builtin_amdgcn_exp2f(p0[r]); }
    PV_M(2, pa1, l0, h0);
    if (act) {
#pragma unroll
        for (int r = 4; r < 8; ++r) p0[r] = __builtin_amdgcn_exp2f(p0[r]); }
    PV_M(3, pa1, l1, h1);
    PV_RD(2);
    if (act) {
#pragma unroll
        for (int r = 8; r < 12; ++r) p0[r] = __builtin_amdgcn_exp2f(p0[r]); }
    PV_M(0, pa2, l0, h0);
    if (act) {
#pragma unroll
        for (int r = 12; r < 16; ++r) p0[r] = __builtin_amdgcn_exp2f(p0[r]); }
    PV_M(1, pa2, l1, h1);
    PV_RD2(2);
    if (act) {
#pragma unroll
        for (int r = 0; r < 4; ++r) p1[r] = __builtin_amdgcn_exp2f(p1[r]); }
    PV_M(2, pa2, l0, h0);
    if (act) {
#pragma unroll
        for (int r = 4; r < 8; ++r) p1[r] = __builtin_amdgcn_exp2f(p1[r]); }
    PV_M(3, pa2, l1, h1);
    PV_RD(3);
    if (act) {
#pragma unroll
        for (int r = 8; r < 12; ++r) p1[r] = __builtin_amdgcn_exp2f(p1[r]); }
    PV_M(0, pa3, l0, h0);
    if (act) {
#pragma unroll
        for (int r = 12; r < 16; ++r) p1[r] = __builtin_amdgcn_exp2f(p1[r]); }
    PV_M(1, pa3, l1, h1);
    PV_RD2(3);
    if (act) {
#pragma unroll
        for (int r = 0; r < 16; ++r) ps += p0[r]; }
    PV_M(2, pa3, l0, h0);
    if (act) {
#pragma unroll
        for (int r = 0; r < 16; ++r) ps += p1[r];
        auto rr = __builtin_amdgcn_permlane32_swap(__float_as_uint(ps), __float_as_uint(ps), false, false);
        ps = __uint_as_float(rr[0]) + __uint_as_float(rr[1]);
        l_reg = l_reg * alpha + ps; }
    PV_M(3, pa3, l1, h1);
#define PK4(P, B_, OUT) do { unsigned a0 = cvt_pk_bf16(P[B_+0], P[B_+1]), a1 = cvt_pk_bf16(P[B_+2], P[B_+3]);                          \
        unsigned b0 = cvt_pk_bf16(P[B_+4], P[B_+5]), b1 = cvt_pk_bf16(P[B_+6], P[B_+7]);                                             \
        auto r0 = __builtin_amdgcn_permlane32_swap(a0, b0, false, false); auto r1 = __builtin_amdgcn_permlane32_swap(a1, b1, false, false); \
        v4u w = {r0[0], r1[0], r0[1], r1[1]}; OUT = *reinterpret_cast<bf16x8*>(&w); } while (0)
    if (act) { PK4(p0, 0, pa0); PK4(p0, 8, pa1); PK4(p1, 0, pa2); PK4(p1, 8, pa3); }
#undef PK4
#undef PV_M
#undef PV_RD
#undef PV_RD2
}

__device__ __forceinline__ void prompt_units(char* lds, LAS unsigned char* ldsl, const bf16* Q, const bf16* Kt, const bf16* Vt, const bf16* SZB, bf16* YB, const float* rel, int it0, int stride, int nit) {
    const int tid = threadIdx.x, wid = __builtin_amdgcn_readfirstlane(tid >> 6), lane = tid & 63, r32 = lane & 31, hi = lane >> 5;
    char* V_lds = lds + OFF_V; char* K_lds = lds + OFF_K; float* tab = (float*)(lds + OFF_TAB);
    float* wsx = (float*)(lds + OFF_WS) + wid * 64; float* li_l = wsx, * al_l = wsx + 32;
    const unsigned voffK0 = (unsigned)(8 * wid + (lane >> 4)) * (DBR * 2) + (unsigned)(((lane & 15) ^ (lane >> 4)) * 16);
    const unsigned voffK1 = (unsigned)(8 * wid + 4 + (lane >> 4)) * (DBR * 2) + (unsigned)(((lane & 15) ^ (4 + (lane >> 4))) * 16);
    const int kkv = 8 * wid + ((lane & 31) >> 2), kv = (kkv & ~0xC) | ((kkv & 4) << 1) | ((kkv & 8) >> 1);
    const unsigned voffV = (unsigned)kv * (DBR * 2) + (unsigned)((lane >> 5) * 64 + (lane & 3) * 16);
    const int vb0 = (int)(uintptr_t)V_lds + v_rd_base(lane);
    const int qo = 32 * (wid & 1) + r32;
    if (it0 >= nit) return;
    bf16x8 qr[8];
#define JLO(qb_) ((4 * (qb_) - 8) > 0 ? (4 * (qb_) - 8) : 0)
#define QLOAD(b_, h_, qb_) do { const bf16* qp_ = Q + (size_t)((b_) * SEQ + (qb_) * 256 + wid * 32 + r32) * DBR + (h_) * HD; \
        _Pragma("unroll") for (int d0 = 0; d0 < 8; ++d0) qr[d0] = *reinterpret_cast<const bf16x8*>(qp_ + d0 * 16 + hi * 8); } while (0)
#define DMA16(gp, lp) __builtin_amdgcn_global_load_lds((const unsigned*)(gp), (LAS unsigned*)(lp), 16, 0, 0)
#define DMA_K(Kp, k0, bf) do { const char* g_ = (const char*)((Kp) + (size_t)(k0) * DBR); LAS unsigned char* l_ = ldsl + OFF_K + (bf) * SHM + wid * 2048; \
        DMA16(g_ + voffK0, l_); DMA16(g_ + voffK1, l_ + 1024); } while (0)
#define DMA_V(Vp, k0, bf) do { const char* g_ = (const char*)((Vp) + (size_t)(k0) * DBR); LAS unsigned char* l_ = ldsl + OFF_V + (bf) * SHM + wid * 2048; \
        DMA16(g_ + voffV, l_); DMA16(g_ + 128 + voffV, l_ + 1024); } while (0)
#define VM_WAIT(n) asm volatile("s_waitcnt vmcnt(" #n ")" ::: "memory")
    int it = it0, hprev = -1;
    { const int qb = it >> 7, bh = it & 127, b = bh >> 4, h = bh & 15;
      if (tid < NREL) tab[tid] = rel[h * NREL + tid] * (1.0f / SCALE); hprev = h;
      QLOAD(b, h, qb); DMA_K(Kt + (size_t)(b * SEQ) * DBR + h * HD, JLO(qb) * 64, 0);
      { const v4u z = {0u, 0u, 0u, 0u}; *(v4u*)(V_lds + 3 * SHM + tid * 32) = z; *(v4u*)(V_lds + 3 * SHM + tid * 32 + 16) = z; }
      VM_WAIT(0); __syncthreads(); }
    for (;;) {
        const int qb = it >> 7, bh = it & 127, b = bh >> 4, h = bh & 15;
        const int rowbase = b * SEQ + qb * 256;
        const int j_lo = JLO(qb), NT = 4 * qb + 4 - j_lo;
        const int cw = 4 * qb + (wid >> 1);
        const bf16* Kh = Kt + (size_t)(b * SEQ) * DBR + h * HD; const bf16* Vh = Vt + (size_t)(b * SEQ) * DBR + h * HD;
        float m_reg = -1e30f, l_reg = 0.f; f32x16 o[4] = {};
        const float tab256 = tab[256];
        bool pend = false; int tl = 0; bf16x8 pa0 = {}, pa1 = {}, pa2 = {}, pa3 = {};
#define STEP(t, BUF) do { \
        DMA_V(Vh, (j_lo + (t)) * 64, (t) & 3); \
        if ((t) + 1 < NT) DMA_K(Kh, (j_lo + (t) + 1) * 64, (BUF) ^ 1); \
        const int cd = cw - (j_lo + (t)); \
        if (cd >= 0 && cd <= 8) { \
            f32x16 p0, p1; \
            if (cd >= 3) { _Pragma("unroll") for (int r = 0; r < 16; ++r) { p0[r] = tab256; p1[r] = tab256; } } \
            else { const int dq = 64 * cd + qo - 4 * hi + 128; \
                _Pragma("unroll") for (int r = 0; r < 16; ++r) { const int c = (r & 3) + 8 * (r >> 2); int i0 = dq - c, i1 = dq - c - 32; i0 = i0 > 256 ? 256 : i0; i1 = i1 > 256 ? 256 : i1; p0[r] = tab[i0]; p1[r] = tab[i1]; } } \
            SBAR(); qkt<0>(p0, p1, K_lds + (BUF) * SHM, r32, hi, qr); \
            float al = 1.f; \
            step_uni(true, o, p0, p1, vb0 + (((t) - 1) & 3) * SHM, m_reg, l_reg, al, pa0, pa1, pa2, pa3);     \
            if (__any(al < 1.f)) { if (hi == 0) al_l[r32] = al; LDS_WAIT(); \
                _Pragma("unroll") for (int d_ = 0; d_ < 4; ++d_) _Pragma("unroll") for (int r = 0; r < 16; ++r) o[d_][r] *= al_l[crow(r, hi)]; } \
            pend = true; tl = (t); \
        } \
        VM_WAIT(0); \
        __syncthreads(); } while (0)
        _Pragma("unroll 1") for (int t = 0; t < NT; ++t) { const int buf = t & 1; STEP(t, buf); }
#undef STEP
        if (pend) pv_tile<0>(o, vb0 + (tl & 3) * SHM, pa0, pa1, pa2, pa3);
        const int itn = it + stride; const bool more = itn < nit;
        if (more) { const int qbn = itn >> 7, bhn = itn & 127, bn = bhn >> 4, hn = bhn & 15;
            DMA_K(Kt + (size_t)(bn * SEQ) * DBR + hn * HD, JLO(qbn) * 64, 0); QLOAD(bn, hn, qbn); }
        if (hi == 0) li_l[r32] = l_reg; LDS_WAIT();
        float rli[16];
#pragma unroll
        for (int r = 0; r < 16; ++r) rli[r] = __builtin_amdgcn_rcpf(li_l[crow(r, hi)]);
        int rb_e = rowbase, h_e = h, r32_e = r32, hi_e = hi; asm volatile("" : "+s"(rb_e), "+s"(h_e), "+v"(r32_e), "+v"(hi_e));
        const int odd = r32_e & 1;
        unsigned zp[16][2];
#pragma unroll
        for (int r = 0; r < 16; ++r) { const size_t go = (size_t)(rb_e + wid * 32 + crow(r, hi_e)) * DBR + h_e * HD + (r32_e - odd) + odd * 32;
#pragma unroll
            for (int p = 0; p < 2; ++p) zp[r][p] = *(const unsigned*)(SZB + go + p * 64); }
#pragma unroll
        for (int r = 0; r < 16; ++r) { const size_t go = (size_t)(rb_e + wid * 32 + crow(r, hi_e)) * DBR + h_e * HD + (r32_e - odd) + odd * 32;
#pragma unroll
            for (int p = 0; p < 2; ++p) { const float va = o[2 * p][r] * rli[r], vb = o[2 * p + 1][r] * rli[r];
                const float keep = odd ? vb : va, recv = __int_as_float(__builtin_amdgcn_mov_dpp(__float_as_int(odd ? va : vb), 0xB1, 0xF, 0xF, true));
                const float lo = odd ? recv : keep, hi_ = odd ? keep : recv;
                *(unsigned*)(YB + go + p * 64) = cvt_pk_bf16(lo * bf_lo(zp[r][p]), hi_ * bf_hi(zp[r][p])); } }
        if (!more) { __syncthreads(); break; }
        { const int hn = (itn & 127) & 15; if (hn != hprev) { if (tid < NREL) tab[tid] = rel[hn * NREL + tid] * (1.0f / SCALE); hprev = hn; } }
        VM_WAIT(32);
        __syncthreads();
        it = itn;
    }
#undef JLO
#undef QLOAD
#undef DMA16
#undef DMA_K
#undef DMA_V
#undef VM_WAIT
}

constexpr int S_OFF_P = 0, S_OFF_ML = 8 * 80 * 16 * 4, S_OFF_OW = S_OFF_ML + 8 * 32 * 4 + 0, S_LDS_NEED = S_OFF_OW + 8 * 16 * 128 * 4;
__device__ __forceinline__ void sample_unit(char* lds, const bf16* Q, const bf16* Kt, const bf16* Vt, const bf16* SZB, bf16* YB, const float* ck, const float* cv, const float* rel, int b, int h) {
    const int tid = threadIdx.x, wid = __builtin_amdgcn_readfirstlane(tid >> 6), lane = tid & 63, l15 = lane & 15, kq = lane >> 4;
    float* Pw = (float*)(lds + S_OFF_P) + wid * 80 * 16; float* ML = (float*)(lds + S_OFF_ML); float* OW = (float*)(lds + S_OFF_OW);
    const int rowbase = MP + b * DECT;
    constexpr float L2E = 1.4426950408889634f;
    bf16x8 qf[4];
#pragma unroll
    for (int ks = 0; ks < 4; ++ks) qf[ks] = *reinterpret_cast<const bf16x8*>(Q + (size_t)(rowbase + l15) * DBR + h * HD + ks * 32 + kq * 8);
    const float* relh = rel + h * NREL;
    const int nblk = (wid == 0) ? 5 : 4;
    float sc[5][4];
#pragma unroll
    for (int kb = 0; kb < 5; ++kb) { if (kb < nblk) {
        f32x4 acc = {0.f, 0.f, 0.f, 0.f};
        if (kb < 4) { const float* kp = ck + ((size_t)(b * CACHE + wid * 64 + kb * 16 + l15) * NH + h) * HD + kq * 8;
#pragma unroll
            for (int ks = 0; ks < 4; ++ks) { const f32x4 x0 = *(const f32x4*)(kp + ks * 32), x1 = *(const f32x4*)(kp + ks * 32 + 4);
                v4u w = {cvt_pk_bf16(x0[0], x0[1]), cvt_pk_bf16(x0[2], x0[3]), cvt_pk_bf16(x1[0], x1[1]), cvt_pk_bf16(x1[2], x1[3])};
                acc = __builtin_amdgcn_mfma_f32_16x16x32_bf16(*reinterpret_cast<bf16x8*>(&w), qf[ks], acc, 0, 0, 0); } }
        else { const bf16* kp = Kt + (size_t)(rowbase + l15) * DBR + h * HD + kq * 8;
#pragma unroll
            for (int ks = 0; ks < 4; ++ks) acc = __builtin_amdgcn_mfma_f32_16x16x32_bf16(*reinterpret_cast<const bf16x8*>(kp + ks * 32), qf[ks], acc, 0, 0, 0); }
#pragma unroll
        for (int i = 0; i < 4; ++i) { int d;
            if (kb < 4) d = l15 + CACHE - (wid * 64 + kb * 16 + 4 * kq + i); else d = l15 - (4 * kq + i);
            d = d > 128 ? 128 : d; sc[kb][i] = (acc[i] * SCALE + relh[d + 128]) * L2E; }
    } else {
#pragma unroll
        for (int i = 0; i < 4; ++i) sc[kb][i] = -1e30f; } }
    float mx = -1e30f;
#pragma unroll
    for (int kb = 0; kb < 5; ++kb)
#pragma unroll
        for (int i = 0; i < 4; ++i) mx = fmaxf(mx, sc[kb][i]);
    mx = fmaxf(mx, __shfl_xor(mx, 16)); mx = fmaxf(mx, __shfl_xor(mx, 32));
    float ls = 0.f;
#pragma unroll
    for (int kb = 0; kb < 5; ++kb)
#pragma unroll
        for (int i = 0; i < 4; ++i) { const float p = (kb < nblk) ? __builtin_amdgcn_exp2f(sc[kb][i] - mx) : 0.f; ls += p; if (kb < nblk) Pw[(kb * 16 + 4 * kq + i) * 16 + l15] = p; }
    ls += __shfl_xor(ls, 16); ls += __shfl_xor(ls, 32);
    if (kq == 0) { ML[wid * 32 + l15] = mx; ML[wid * 32 + 16 + l15] = ls; }
    LDS_WAIT();
    f32x2 ov[16];
#pragma unroll
    for (int q = 0; q < 16; ++q) ov[q] = (f32x2){0.f, 0.f};
    const float* vp = cv + ((size_t)(b * CACHE + wid * 64) * NH + h) * HD + 2 * lane;
#pragma unroll 4
    for (int k = 0; k < 64; ++k) { const f32x2 v = *(const f32x2*)(vp + (size_t)k * NH * HD); const f32x4* pr = (const f32x4*)(Pw + k * 16);
#pragma unroll
        for (int q4 = 0; q4 < 4; ++q4) { const f32x4 p = pr[q4];
            ov[4 * q4 + 0] += v * p[0]; ov[4 * q4 + 1] += v * p[1]; ov[4 * q4 + 2] += v * p[2]; ov[4 * q4 + 3] += v * p[3]; } }
    if (wid == 0) {
        for (int k = 0; k < 16; ++k) { const unsigned vw = *(const unsigned*)(Vt + (size_t)(rowbase + k) * DBR + h * HD + 2 * lane); const f32x2 v = {bf_lo(vw), bf_hi(vw)}; const f32x4* pr = (const f32x4*)(Pw + (64 + k) * 16);
#pragma unroll
            for (int q4 = 0; q4 < 4; ++q4) { const f32x4 p = pr[q4];
                ov[4 * q4 + 0] += v * p[0]; ov[4 * q4 + 1] += v * p[1]; ov[4 * q4 + 2] += v * p[2]; ov[4 * q4 + 3] += v * p[3]; } }
    }
#pragma unroll
    for (int q = 0; q < 16; ++q) *(f32x2*)(OW + (wid * 16 + q) * 128 + 2 * lane) = ov[q];
    __syncthreads();
    { const int q = tid >> 5, d = (tid & 31) * 4; float mw[8], Mx = -1e30f;
#pragma unroll
      for (int w = 0; w < 8; ++w) { mw[w] = ML[w * 32 + q]; Mx = fmaxf(Mx, mw[w]); }
      float L = 0.f; f32x4 a = {0.f, 0.f, 0.f, 0.f};
#pragma unroll
      for (int w = 0; w < 8; ++w) { const float e = __builtin_amdgcn_exp2f(mw[w] - Mx); L += e * ML[w * 32 + 16 + q]; a += *(const f32x4*)(OW + (w * 16 + q) * 128 + d) * e; }
      const float rl = 1.0f / L; const size_t go = (size_t)(rowbase + q) * DBR + h * HD + d;
      const v2u z = *(const v2u*)(SZB + go);
      v2u w2; w2.x = cvt_pk_bf16(a[0] * rl * bf_lo(z.x), a[1] * rl * bf_hi(z.x)); w2.y = cvt_pk_bf16(a[2] * rl * bf_lo(z.y), a[3] * rl * bf_hi(z.y));
      *(v2u*)(YB + go) = w2; }
    __syncthreads();
}
}

namespace sgu {
constexpr int PITCH = 272;
constexpr int OFF_VNT = 0, OFF_W = 256 * PITCH, LDS_NEED = OFF_W + 128 * PITCH;
__device__ __forceinline__ void prompt_unit(LAS unsigned char* lds, const bf16* VN, const bf16* UZ, bf16* YA, const bf16* Wm, const float* bs, int b, int n, int g) {
    const int tid = threadIdx.x, wid = __builtin_amdgcn_readfirstlane(tid >> 6), lane = tid & 63, r32 = lane & 31, hi = lane >> 5;
    const int row0 = b * SEQ + n * GCH, c0 = g * GDIM;
#pragma unroll
    for (int it = 0; it < 4; ++it) { const int p = tid + it * 512, r = p >> 4, cpc = p & 15;
        *(LAS v4u*)(lds + OFF_W + r * PITCH + cpc * 16) = *(const v4u*)(Wm + (size_t)g * GCH * GCH + r * GCH + cpc * 8); }
#pragma unroll
    for (int it = 0; it < 4; ++it) { const int cg = wid * 4 + it, jj = lane;
        const v4u a = *(const v4u*)(VN + (size_t)(row0 + 2 * jj) * DBR + c0 + cg * 8), bb = *(const v4u*)(VN + (size_t)(row0 + 2 * jj + 1) * DBR + c0 + cg * 8);
        LAS unsigned char* dst = lds + OFF_VNT + (cg * 8) * PITCH + jj * 4;
        *(LAS unsigned*)(dst + 0 * PITCH) = (a.x & 0xffffu) | (bb.x << 16); *(LAS unsigned*)(dst + 1 * PITCH) = (a.x >> 16) | (bb.x & 0xffff0000u);
        *(LAS unsigned*)(dst + 2 * PITCH) = (a.y & 0xffffu) | (bb.y << 16); *(LAS unsigned*)(dst + 3 * PITCH) = (a.y >> 16) | (bb.y & 0xffff0000u);
        *(LAS unsigned*)(dst + 4 * PITCH) = (a.z & 0xffffu) | (bb.z << 16); *(LAS unsigned*)(dst + 5 * PITCH) = (a.z >> 16) | (bb.z & 0xffff0000u);
        *(LAS unsigned*)(dst + 6 * PITCH) = (a.w & 0xffffu) | (bb.w << 16); *(LAS unsigned*)(dst + 7 * PITCH) = (a.w >> 16) | (bb.w & 0xffff0000u); }
    __syncthreads();
    f32x16 acc[4] = {};
#pragma unroll
    for (int ks = 0; ks < 8; ++ks) {
        const bf16x8 a = *(const LAS bf16x8*)(lds + OFF_VNT + (wid * 32 + r32) * PITCH + (ks * 16 + hi * 8) * 2);
#pragma unroll
        for (int ib = 0; ib < 4; ++ib) { if (ib < 2 && ks >= 4) continue;
            const bf16x8 w = *(const LAS bf16x8*)(lds + OFF_W + (ib * 32 + r32) * PITCH + (ks * 16 + hi * 8) * 2);
            acc[ib] = __builtin_amdgcn_mfma_f32_32x32x16_bf16(a, w, acc[ib], 0, 0, 0); } }
    v2u uu[4][4]; float bsv[4];
#pragma unroll
    for (int ib = 0; ib < 4; ++ib) { const int i = ib * 32 + r32; bsv[ib] = bs[g * GCH + i]; const size_t ro = (size_t)(row0 + i) * DBR + c0 + wid * 32 + 4 * hi;
#pragma unroll
        for (int rq = 0; rq < 4; ++rq) uu[ib][rq] = *(const v2u*)(UZ + ro + 8 * rq); }
#pragma unroll
    for (int ib = 0; ib < 4; ++ib) { const int i = ib * 32 + r32; const float bsi = bsv[ib]; const size_t ro = (size_t)(row0 + i) * DBR + c0 + wid * 32 + 4 * hi;
#pragma unroll
        for (int rq = 0; rq < 4; ++rq) { const size_t go = ro + 8 * rq; const v2u u2 = uu[ib][rq];
            const float y0 = bf_lo(u2.x) * (acc[ib][4 * rq + 0] + bsi), y1 = bf_hi(u2.x) * (acc[ib][4 * rq + 1] + bsi);
            const float y2 = bf_lo(u2.y) * (acc[ib][4 * rq + 2] + bsi), y3 = bf_hi(u2.y) * (acc[ib][4 * rq + 3] + bsi);
            v2u w2; w2.x = cvt_pk_bf16(y0, y1); w2.y = cvt_pk_bf16(y2, y3); *(v2u*)(YA + go) = w2; } }
    __syncthreads();
}
__device__ __forceinline__ void prompt_stream(LAS unsigned char* lds, const bf16* VN, const bf16* UZ, bf16* YA, const bf16* Wm, const float* bs, int it0, int stride, int nit) {
    if (it0 >= nit) return;
    const int tid = threadIdx.x, wid = __builtin_amdgcn_readfirstlane(tid >> 6), lane = tid & 63, r32 = lane & 31, hi = lane >> 5;
    v4u va[4], vb[4];
#define SG_VLOAD(it_) do { const int b_ = (it_) >> 7, n_ = ((it_) >> 3) & 15, g_ = (it_) & 7; const size_t ro_ = (size_t)(b_ * SEQ + n_ * GCH + 2 * lane) * DBR + g_ * GDIM + wid * 32; \
        _Pragma("unroll") for (int i_ = 0; i_ < 4; ++i_) { va[i_] = *(const v4u*)(VN + ro_ + i_ * 8); vb[i_] = *(const v4u*)(VN + ro_ + DBR + i_ * 8); } } while (0)
#define SG_VWRITE() do { _Pragma("unroll") for (int i_ = 0; i_ < 4; ++i_) { const v4u a = va[i_], bb = vb[i_]; LAS unsigned char* dst = lds + OFF_VNT + ((wid * 4 + i_) * 8) * PITCH + lane * 4; \
        *(LAS unsigned*)(dst + 0 * PITCH) = (a.x & 0xffffu) | (bb.x << 16); *(LAS unsigned*)(dst + 1 * PITCH) = (a.x >> 16) | (bb.x & 0xffff0000u); \
        *(LAS unsigned*)(dst + 2 * PITCH) = (a.y & 0xffffu) | (bb.y << 16); *(LAS unsigned*)(dst + 3 * PITCH) = (a.y >> 16) | (bb.y & 0xffff0000u); \
        *(LAS unsigned*)(dst + 4 * PITCH) = (a.z & 0xffffu) | (bb.z << 16); *(LAS unsigned*)(dst + 5 * PITCH) = (a.z >> 16) | (bb.z & 0xffff0000u); \
        *(LAS unsigned*)(dst + 6 * PITCH) = (a.w & 0xffffu) | (bb.w << 16); *(LAS unsigned*)(dst + 7 * PITCH) = (a.w >> 16) | (bb.w & 0xffff0000u); } } while (0)
#define SG_WLOAD(g_) do { _Pragma("unroll") for (int i_ = 0; i_ < 4; ++i_) { const int p = tid + i_ * 512, r = p >> 4, cpc = p & 15; \
        *(LAS v4u*)(lds + OFF_W + r * PITCH + cpc * 16) = *(const v4u*)(Wm + (size_t)(g_) * GCH * GCH + r * GCH + cpc * 8); } } while (0)
    int it = it0, gprev = it0 & 7;
    SG_VLOAD(it); SG_WLOAD(gprev); SG_VWRITE();
    __syncthreads();
    for (;;) {
        const int b = it >> 7, n = (it >> 3) & 15, g = it & 7, row0 = b * SEQ + n * GCH, c0 = g * GDIM;
        v2u uu[4][4]; float bsv[4];
#pragma unroll
        for (int ib = 0; ib < 4; ++ib) { const int i = ib * 32 + r32; bsv[ib] = bs[g * GCH + i]; const size_t ro = (size_t)(row0 + i) * DBR + c0 + wid * 32 + 4 * hi;
#pragma unroll
            for (int rq = 0; rq < 4; ++rq) uu[ib][rq] = *(const v2u*)(UZ + ro + 8 * rq); }
        const int itn = it + stride; const bool more = itn < nit;
        if (more) SG_VLOAD(itn);
        f32x16 acc[4] = {};
#pragma unroll
        for (int ks = 0; ks < 8; ++ks) {
            const bf16x8 a = *(const LAS bf16x8*)(lds + OFF_VNT + (wid * 32 + r32) * PITCH + (ks * 16 + hi * 8) * 2);
#pragma unroll
            for (int ib = 0; ib < 4; ++ib) { if (ib < 2 && ks >= 4) continue;
                const bf16x8 w = *(const LAS bf16x8*)(lds + OFF_W + (ib * 32 + r32) * PITCH + (ks * 16 + hi * 8) * 2);
                acc[ib] = __builtin_amdgcn_mfma_f32_32x32x16_bf16(a, w, acc[ib], 0, 0, 0); } }
        __syncthreads();
        if (more) { const int gn = itn & 7; if (gn != gprev) { SG_WLOAD(gn); gprev = gn; } SG_VWRITE(); }
#pragma unroll
        for (int ib = 0; ib < 4; ++ib) { const int i = ib * 32 + r32; const float bsi = bsv[ib]; const size_t ro = (size_t)(row0 + i) * DBR + c0 + wid * 32 + 4 * hi;
#pragma unroll
            for (int rq = 0; rq < 4; ++rq) { const size_t go = ro + 8 * rq; const v2u u2 = uu[ib][rq];
                const float y0 = bf_lo(u2.x) * (acc[ib][4 * rq + 0] + bsi), y1 = bf_hi(u2.x) * (acc[ib][4 * rq + 1] + bsi);
                const float y2 = bf_lo(u2.y) * (acc[ib][4 * rq + 2] + bsi), y3 = bf_hi(u2.y) * (acc[ib][4 * rq + 3] + bsi);
                v2u w2; w2.x = cvt_pk_bf16(y0, y1); w2.y = cvt_pk_bf16(y2, y3); *(v2u*)(YA + go) = w2; } }
        __syncthreads();
        if (!more) break;
        it = itn;
    }
#undef SG_VLOAD
#undef SG_VWRITE
#undef SG_WLOAD
}
__device__ __forceinline__ void sample_unit(const bf16* VN, const bf16* UZ, bf16* YA, const float* w_s, const float* bs, int b, int iq) {
    const int tid = threadIdx.x, c = tid * 4, g = c >> 8; const int row0 = MP + b * DECT;
    f32x4 v[16];
#pragma unroll
    for (int j = 0; j < 16; ++j) { const v2u x = *(const v2u*)(VN + (size_t)(row0 + j) * DBR + c); v[j] = (f32x4){bf_lo(x.x), bf_hi(x.x), bf_lo(x.y), bf_hi(x.y)}; }
    v2u uq[4];
#pragma unroll
    for (int ii = 0; ii < 4; ++ii) { const size_t go = (size_t)(row0 + iq * 4 + ii) * DBR + c; uq[ii] = *(const v2u*)(UZ + go); }
#pragma unroll
    for (int ii = 0; ii < 4; ++ii) { const int i = iq * 4 + ii; const float* wr = w_s + ((size_t)g * GCH + i) * GCH; const float bsi = bs[g * GCH + i]; f32x4 a = {bsi, bsi, bsi, bsi};
        const size_t go = (size_t)(row0 + i) * DBR + c; const v2u u2 = uq[ii];
#pragma unroll
        for (int j = 0; j < 16; ++j) a += v[j] * wr[j];
        v2u w2; w2.x = cvt_pk_bf16(bf_lo(u2.x) * a[0], bf_hi(u2.x) * a[1]); w2.y = cvt_pk_bf16(bf_lo(u2.y) * a[2], bf_hi(u2.y) * a[3]);
        *(v2u*)(YA + go) = w2; }
}
}

constexpr int NWAVES = 8;
constexpr int N_PHASES = 8;
constexpr int N_LAUNCHES = MK_N_LAUNCHES;
constexpr int RING_OFF = 0, RING_BYTES = 131072;
constexpr int LDSCTL_OFF = 143360, MISC_OFF = LDSCTL_OFF + 320;
constexpr int LDS_BYTES = 147456;
static_assert(att::LDS_NEED <= LDSCTL_OFF && att::S_LDS_NEED <= LDSCTL_OFF && sgu::LDS_NEED <= LDSCTL_OFF && 8 * 64 * 65 * 4 <= LDSCTL_OFF && MISC_OFF + 128 <= LDS_BYTES, "LDS map");

#define XB_TMO      128
#define XB_XCNT(j)  (256  + 64 * (j))
#define XB_XSUB(j)  (1280 + 64 * (j))
#define XB_XGEN(j)  (2304 + 64 * (j))
#define XB_TOP      3328
#define XB_TOPGEN   3392
#define XCD_BAR_WORDS 3456
#define XB_SPIN_CAP (1u << 18)
__device__ __forceinline__ unsigned xb_ld(unsigned* p)              { return __hip_atomic_load(p, __ATOMIC_RELAXED, __HIP_MEMORY_SCOPE_AGENT); }
__device__ __forceinline__ unsigned xb_add(unsigned* p, unsigned v) { return __hip_atomic_fetch_add(p, v, __ATOMIC_RELAXED, __HIP_MEMORY_SCOPE_AGENT); }
__device__ __forceinline__ unsigned xb_xcc_id() { return (unsigned)__builtin_amdgcn_s_getreg((3 << 11) | 20) & 0xFu; }
#define XB_SPIN(cond, bar) do { unsigned _sp = 0; while (cond) { __builtin_amdgcn_s_sleep(1); \
    if ((++_sp & 255u) == 0u) { if (xb_ld(&(bar)[XB_TMO])) break; if (_sp > XB_SPIN_CAP) { atomicAdd(&(bar)[XB_TMO], 1u); break; } } } } while (0)
struct XcdBarrier { unsigned* bar; unsigned x; volatile LAS unsigned* st; };
__device__ __forceinline__ XcdBarrier xcd_barrier_post(unsigned* bar, volatile LAS unsigned* st) {
    XcdBarrier b; b.bar = bar; b.x = xb_xcc_id(); b.st = st;
    if (threadIdx.x == 0) (void)xb_add(&bar[XB_XCNT(b.x)], 1u);
    return b;
}
__device__ __forceinline__ void xcd_barrier_complete(unsigned* bar, unsigned x, unsigned& nloc, unsigned& nx) {
    const unsigned G = gridDim.x * gridDim.y * gridDim.z;
    unsigned sum, cnt, mine, sp = 0u;
    for (;;) {
        sum = 0u; cnt = 0u; mine = 0u;
#pragma unroll
        for (unsigned j = 0; j < 16; ++j) { const unsigned c = xb_ld(&bar[XB_XCNT(j)]); sum += c; cnt += (c > 0u) ? 1u : 0u; mine = (j == x) ? c : mine; }
        if (sum == G) break;
        __builtin_amdgcn_s_sleep(1);
        if ((++sp & 255u) == 0u) { if (xb_ld(&bar[XB_TMO])) break; if (sp > XB_SPIN_CAP) { atomicAdd(&bar[XB_TMO], 1u); break; } }
    }
    nloc = mine > 0u ? mine : 1u; nx = cnt > 0u ? cnt : 1u;
}
__device__ __forceinline__ void xcd_barrier(const XcdBarrier& b) {
    asm volatile("s_waitcnt vmcnt(0)" ::: "memory");
    __syncthreads();
    if (threadIdx.x == 0) {
        unsigned* bar = b.bar;
        __builtin_amdgcn_s_waitcnt(0);
        unsigned nloc = b.st[0], nx = b.st[1];
        if (nloc == 0u) { xcd_barrier_complete(bar, b.x, nloc, nx); b.st[0] = nloc; b.st[1] = nx; }
        const unsigned old = xb_add(&bar[XB_XSUB(b.x)], 1u);
        const unsigned gen = old / nloc;
        if (old + 1u == (gen + 1u) * nloc) {
            __builtin_amdgcn_fence(__ATOMIC_RELEASE, "agent");
            asm volatile("s_waitcnt vmcnt(0)" ::: "memory");
            const unsigned og = xb_add(&bar[XB_TOP], 1u);
            const unsigned tg = og / nx;
            if (og + 1u == (tg + 1u) * nx) xb_add(&bar[XB_TOPGEN], 1u);
            else XB_SPIN(xb_ld(&bar[XB_TOPGEN]) == tg, bar);
            __builtin_amdgcn_fence(__ATOMIC_ACQUIRE, "agent");
            xb_add(&bar[XB_XGEN(b.x)], 1u);
            asm volatile("s_waitcnt vmcnt(0)" ::: "memory");
        } else {
            XB_SPIN(xb_ld(&bar[XB_XGEN(b.x)]) == gen, bar);
            __builtin_amdgcn_fence(__ATOMIC_ACQUIRE, "agent");
            asm volatile("s_waitcnt vmcnt(0)" ::: "memory");
        }
    }
    __syncthreads();
}

__device__ __forceinline__ int win_src_col(int np) {
    if (np < 2 * DBR) { const int c4 = np >> 3, e = np & 3, hf = (np >> 2) & 1; return (hf ? 2 * DBR : 0) + 4 * c4 + e; }
    if (np < 3 * DBR) return np - 2 * DBR + DBR;
    if (np < 7 * DBR) return np;
    { const int m = np - 7 * DBR, c4 = m >> 3, e = m & 3, hf = (m >> 2) & 1; return 7 * DBR + (hf ? DM : 0) + 4 * c4 + e; }
}
template <bool PERMC>
__device__ __forceinline__ void transpose_item(const float* W, int K, int N, bf16* WT, LAS float* scr, int item, int lane) {
    const int nblk = N / 64, kb = item / nblk, nb = item % nblk, k0 = 64 * kb, n0 = 64 * nb;
    const float* src = W + (size_t)k0 * N + (PERMC ? win_src_col(n0 + lane) : n0 + lane);
    float v[64];
#pragma unroll
    for (int i = 0; i < 64; ++i) v[i] = src[(size_t)i * N];
#pragma unroll
    for (int i = 0; i < 64; ++i) scr[i * 65 + lane] = v[i];
    LDS_WAIT(); asm volatile("" ::: "memory");
    const int c = lane & 7;
#pragma unroll
    for (int j = 0; j < 8; ++j) { const int n = (lane >> 3) + 8 * j; const LAS float* s = scr + (8 * c) * 65 + n;
        v4u o; o.x = cvt_pk_bf16(s[0 * 65], s[1 * 65]); o.y = cvt_pk_bf16(s[2 * 65], s[3 * 65]); o.z = cvt_pk_bf16(s[4 * 65], s[5 * 65]); o.w = cvt_pk_bf16(s[6 * 65], s[7 * 65]);
        *(v4u*)(WT + (size_t)(n0 + n) * K + k0 + 8 * c) = o; }
    LDS_WAIT(); asm volatile("" ::: "memory");
}
#define RMS_LOAD(V, xrow_) do { const f32x4* xr_ = (const f32x4*)(xrow_) + lane; _Pragma("unroll") for (int j = 0; j < 16; ++j) V[j] = xr_[64 * j]; } while (0)
#define RMS_PROC(V, orow_) do { float s_ = 0.f; _Pragma("unroll") for (int j = 0; j < 16; ++j) s_ += (V[j].x * V[j].x + V[j].y * V[j].y) + (V[j].z * V[j].z + V[j].w * V[j].w); \
        const float r_ = 1.0f / sqrtf(wave_sum(s_) * (1.f / DM) + EPS); v2u* o8_ = (v2u*)(orow_) + lane; \
        _Pragma("unroll") for (int j = 0; j < 16; ++j) { const f32x4 gg = ((const LAS f32x4*)gl)[lane + 64 * j]; v2u w; w.x = cvt_pk_bf16(V[j].x * r_ * gg.x, V[j].y * r_ * gg.y); w.y = cvt_pk_bf16(V[j].z * r_ * gg.z, V[j].w * r_ * gg.w); o8_[64 * j] = w; } } while (0)

struct Args { const float* in[19]; float* out; unsigned char* ws; int ph_lo, ph_hi, li, pad; };

__global__ void __launch_bounds__(NWAVES * 64, 2) fwd_kernel(Args args) {
    extern __shared__ __attribute__((aligned(16))) unsigned char lds_raw[];
    LAS unsigned char* lds = (LAS unsigned char*)lds_raw;
    const int tid = threadIdx.x, lane = tid & 63, wave = __builtin_amdgcn_readfirstlane(tid >> 6);
    const int G = gridDim.x, bx = blockIdx.x;
    const int vcu = (G % 8 == 0) ? (bx % 8) * (G / 8) + bx / 8 : bx;
    unsigned char* ws = args.ws;
    gu32* ctl = (gu32*)(ws + WS_CTL);
    const float* x_prompt = args.in[0]; const float* x_sample = args.in[1]; const float* cache_k = args.in[2]; const float* cache_v = args.in[3];
    const float* p_prompt = args.in[4]; const float* p_sample = args.in[5]; const float* pre_g = args.in[6]; const float* post_g = args.in[7];
    const float* w_in = args.in[8]; const float* ln_g = args.in[9]; const float* ln_b = args.in[10]; const float* w_s = args.in[11]; const float* b_s = args.in[12];
    const float* rel_bias = args.in[13]; const float* w_up_a = args.in[14]; const float* w_up_b = args.in[15]; const float* w_out = args.in[16];
    const float* w_pg = args.in[17]; const float* w_pp = args.in[18];
    float* out = args.out;
    bf16* WIN_T = (bf16*)(ws + WS_WIN); bf16* WUA_T = (bf16*)(ws + WS_WUA); bf16* WUB_T = (bf16*)(ws + WS_WUB); bf16* WOUT_T = (bf16*)(ws + WS_WOUT);
    bf16* WPG_T = (bf16*)(ws + WS_WPG); bf16* WPP_T = (bf16*)(ws + WS_WPP); bf16* WSM = (bf16*)(ws + WS_WS); bf16* PB = (bf16*)(ws + WS_PB);
    bf16* HB = (bf16*)(ws + WS_H); bf16* YA = (bf16*)(ws + WS_H); bf16* YB = (bf16*)(ws + WS_H + SEG2K);
    bf16* SEG = (bf16*)(ws + WS_SEG);
    bf16* GU = SEG; bf16* GV = SEG + (size_t)M * DBR; bf16* SZA = SEG + (size_t)2 * M * DBR; bf16* QB = SEG + (size_t)3 * M * DBR; bf16* KB = SEG + (size_t)4 * M * DBR;
    bf16* VB = SEG + (size_t)5 * M * DBR; bf16* SZB = SEG + (size_t)6 * M * DBR; bf16* SGA = SEG + (size_t)7 * M * DBR; bf16* SGB = SGA + (size_t)M * DM;
    bf16* SLAB = (bf16*)(ws + WS_SLAB); bf16* PBUF = (bf16*)(ws + WS_P); bf16* MBUF = (bf16*)(ws + WS_MBUF); bf16* TB = (bf16*)(ws + WS_T); bf16* X1B = (bf16*)(ws + WS_X1B);

    for (int u = tid; u < (LDS_BYTES - LDSCTL_OFF) / 4; u += NWAVES * 64) ((LAS unsigned*)(lds + LDSCTL_OFF))[u] = 0u;
    __syncthreads();
    volatile LAS unsigned* MISC = (volatile LAS unsigned*)(lds + MISC_OFF);
    XcdBarrier bar; bar.bar = (unsigned*)(ctl + CW_BAR); bar.x = 0; bar.st = nullptr;
    if (N_LAUNCHES == 1) bar = xcd_barrier_post((unsigned*)(ctl + CW_BAR), MISC + 8);
#define GRID_BAR() do { if (N_LAUNCHES == 1) xcd_barrier(bar); } while (0)
    const int lo = args.ph_lo, hi = args.ph_hi;
#define IN(k) (lo <= (k) && (k) < hi)
#define BOTH(k) (IN(k) && IN((k) + 1))
    const int gw = vcu * NWAVES + wave, NGW = G * NWAVES;

    if (IN(0)) {
        LAS float* scr = (LAS float*)(lds + wave * (64 * 65 * 4));
        constexpr int I_IN = (DM / 64) * (NIN / 64), I_UP = (DBR / 64) * (DM / 64), I_SQ = (DM / 64) * (DM / 64), I_PP = (PLE / 64) * (DM / 64);
        constexpr int NITEMS = I_IN + 2 * I_UP + 2 * I_SQ + I_PP;
        for (int it = gw; it < NITEMS; it += NGW) {
            int r = it;
            if (r < I_IN) { transpose_item<true>(w_in, DM, NIN, WIN_T, scr, r, lane); continue; } r -= I_IN;
            if (r < I_UP) { transpose_item<false>(w_up_a, DBR, DM, WUA_T, scr, r, lane); continue; } r -= I_UP;
            if (r < I_UP) { transpose_item<false>(w_up_b, DBR, DM, WUB_T, scr, r, lane); continue; } r -= I_UP;
            if (r < I_SQ) { transpose_item<false>(w_out, DM, DM, WOUT_T, scr, r, lane); continue; } r -= I_SQ;
            if (r < I_SQ) { transpose_item<false>(w_pg, DM, DM, WPG_T, scr, r, lane); continue; } r -= I_SQ;
            transpose_item<false>(w_pp, PLE, DM, WPP_T, scr, r, lane);
        }
        { __syncthreads();
          LAS float* gl = (LAS float*)lds;
          for (int i = tid; i < DM / 4; i += NWAVES * 64) ((LAS f32x4*)gl)[i] = ((const f32x4*)pre_g)[i];
          __syncthreads();
#define XROW(m_) ((m_) < MP ? x_prompt + (size_t)(m_) * DM : x_sample + (size_t)((m_) - MP) * DM)
          const int m0 = (NGW == 2048 ? ((gw + 1024) & 2047) : gw);
          f32x4 va[16], vb[16];
          if (m0 < M) RMS_LOAD(va, XROW(m0));
          for (int m = m0; m < M; m += 2 * NGW) {
              if (m + NGW < M) RMS_LOAD(vb, XROW(m + NGW));
              asm volatile("" ::: "memory");
              RMS_PROC(va, HB + (size_t)m * DM);
              if (m + NGW < M) { if (m + 2 * NGW < M) RMS_LOAD(va, XROW(m + 2 * NGW));
                  asm volatile("" ::: "memory");
                  RMS_PROC(vb, HB + (size_t)(m + NGW) * DM); } }
#undef XROW
        }
        { const int gt = vcu * 512 + tid, NT_ = G * 512;
          for (int i = gt; i < M * PLE / 4; i += NT_) { const int m = (i * 4) / PLE; const f32x4 v = (m < MP) ? ((const f32x4*)p_prompt)[i] : ((const f32x4*)p_sample)[i - MP * PLE / 4];
              v2u w; w.x = cvt_pk_bf16(v.x, v.y); w.y = cvt_pk_bf16(v.z, v.w); ((v2u*)PB)[i] = w; }
          for (int i = gt; i < NGRP * GCH * GCH; i += NT_) { const int ii = (i >> 7) & 127, jj = i & 127; const float v = ((jj >> 6) <= (ii >> 6)) ? w_s[i] : 0.f; WSM[i] = (bf16)(cvt_pk_bf16(v, 0.f) & 0xffffu); } }
        if (BOTH(0)) GRID_BAR();
    }
    if (IN(1)) {
#pragma unroll 1
        for (int pass = 0; pass < 2; ++pass) {
            const int pmo = pass ? MP / 256 : 0; const bf16* Ap = HB + (size_t)pmo * 256 * DM;
            pg8::Order S; S.init(Ap, WIN_T, Ap, WIN_T, DM, DM, pass ? MS : MP, NIN, DM, 1, G, bx, 0, 0, 0);
            pg8::EpiIn E{SEG, out, pmo};
            pg8::gemm_phase<pg8::EpiIn, false>(lds + RING_OFF, S, E);
        }
#pragma unroll 1
        for (int part = 0; part < 2; ++part) {
            const bool split = (G == 256);
            pg8::Order S; S.init(PB, WPP_T, PB, WPP_T, PLE, PLE, M, DM, PLE, 1, (split && !part) ? 80 : G, (split && !part) ? bx - 176 : bx, 0, 0, 0);
            if (split) S.set_range(part ? 960 : 0, part ? 1056 : 960); else if (part) S.set_range(0, 0);
            pg8::EpiStore E{PBUF, DM, nullptr, 0};
            pg8::gemm_phase<pg8::EpiStore>(lds + RING_OFF, S, E);
        }
        if (BOTH(1)) GRID_BAR();
    }
    if (IN(2)) {
        f32x4 lg[4][2], lb[4][2];
#pragma unroll
        for (int j = 0; j < 4; ++j) { const int c = (lane + 64 * j) * 8; lg[j][0] = *(const f32x4*)(ln_g + c); lg[j][1] = *(const f32x4*)(ln_g + c + 4); lb[j][0] = *(const f32x4*)(ln_b + c); lb[j][1] = *(const f32x4*)(ln_b + c + 4); }
#define LN_LOAD(W_, m_) do { const v4u* rp_ = (const v4u*)(GV + (size_t)(m_) * DBR) + lane; _Pragma("unroll") for (int j = 0; j < 4; ++j) W_[j] = rp_[64 * j]; } while (0)
#define LN_PROC(W_, m_) do { const int mm = (m_); v4u* rp = (v4u*)(GV + (size_t)mm * DBR) + lane;     \
            float v[32]; float s = 0.f; \
            _Pragma("unroll") for (int j = 0; j < 4; ++j) { const v4u w = W_[j]; v[8 * j + 0] = bf_lo(w.x); v[8 * j + 1] = bf_hi(w.x); v[8 * j + 2] = bf_lo(w.y); v[8 * j + 3] = bf_hi(w.y); \
                v[8 * j + 4] = bf_lo(w.z); v[8 * j + 5] = bf_hi(w.z); v[8 * j + 6] = bf_lo(w.w); v[8 * j + 7] = bf_hi(w.w); } \
            _Pragma("unroll") for (int j = 0; j < 32; ++j) s += v[j]; \
            const float mean = wave_sum(s) * (1.f / DBR); float s2 = 0.f; \
            _Pragma("unroll") for (int j = 0; j < 32; ++j) { v[j] -= mean; s2 += v[j] * v[j]; } \
            const float rstd = 1.0f / sqrtf(wave_sum(s2) * (1.f / DBR) + EPS); \
            float* fo = nullptr; \
            if (mm >= MP) fo = out + OFF_GS + (size_t)(mm - MP) * DBR; else if ((mm & (SEQ - 1)) >= SEQ - GCH) fo = out + OFF_GP + (size_t)((mm >> 11) * GCH + (mm & (SEQ - 1)) - (SEQ - GCH)) * DBR; \
            _Pragma("unroll") for (int j = 0; j < 4; ++j) { const int c = (lane + 64 * j) * 8; const f32x4 g0 = lg[j][0], g1 = lg[j][1], b0 = lb[j][0], b1 = lb[j][1]; \
                f32x4 y0, y1; y0[0] = v[8 * j + 0] * rstd * g0[0] + b0[0]; y0[1] = v[8 * j + 1] * rstd * g0[1] + b0[1]; y0[2] = v[8 * j + 2] * rstd * g0[2] + b0[2]; y0[3] = v[8 * j + 3] * rstd * g0[3] + b0[3]; \
                y1[0] = v[8 * j + 4] * rstd * g1[0] + b1[0]; y1[1] = v[8 * j + 5] * rstd * g1[1] + b1[1]; y1[2] = v[8 * j + 6] * rstd * g1[2] + b1[2]; y1[3] = v[8 * j + 7] * rstd * g1[3] + b1[3]; \
                if (fo) { *(f32x4*)(fo + c) = y0; *(f32x4*)(fo + c + 4) = y1; } \
                v4u w; w.x = cvt_pk_bf16(y0[0], y0[1]); w.y = cvt_pk_bf16(y0[2], y0[3]); w.z = cvt_pk_bf16(y1[0], y1[1]); w.w = cvt_pk_bf16(y1[2], y1[3]); rp[64 * j] = w; } } while (0)
        { v4u wa[4], wb[4];
          if (gw < M) LN_LOAD(wa, gw);
          for (int m = gw; m < M; m += 2 * NGW) {
              if (m + NGW < M) LN_LOAD(wb, m + NGW);
              asm volatile("" ::: "memory");
              LN_PROC(wa, m);
              if (m + NGW < M) { if (m + 2 * NGW < M) LN_LOAD(wa, m + 2 * NGW);
                  asm volatile("" ::: "memory");
                  LN_PROC(wb, m + NGW); } } }
#undef LN_LOAD
#undef LN_PROC
        if (BOTH(2)) GRID_BAR();
    }
    if (IN(3)) {
        att::prompt_units((char*)lds_raw, lds, QB, KB, VB, SZB, YB, rel_bias, bx, G, NB * NH * 8);
        for (int it = bx; it < DECB * NH; it += G) att::sample_unit((char*)lds_raw, QB, KB, VB, SZB, YB, cache_k, cache_v, rel_bias, it >> 4, it & 15);
        sgu::prompt_stream(lds, GV, GU, YA, WSM, b_s, bx, G, NB * 16 * NGRP);
        for (int it = bx; it < DECB * 4; it += (G == 256 ? 128 : G)) { if (G == 256 && bx >= 128) break; sgu::sample_unit(GV, GU, YA, w_s, b_s, it >> 2, it & 3); }
        if (BOTH(3)) GRID_BAR();
    }
    if (IN(4)) {
        { pg8::Order S; S.init(YA, WUA_T, YB, WUB_T, DBR, DBR, MP, DM, DBR, 2, G, bx, 0, 0, 0);
          pg8::EpiMerge E{SGA, SGB, MBUF};
          pg8::gemm_phase<pg8::EpiMerge>(lds + RING_OFF, S, E); }
        { pg8::Order S; S.init(YA, WUA_T, YB, WUB_T, DBR, DBR, 0, DM, DBR, 2, G, bx, MS, 8, MP / 256);
          pg8::EpiMergeSub E{SGA, SGB, SLAB, MP / 256};
          pg8::gemm_phase<pg8::EpiMergeSub>(lds + RING_OFF, S, E); }
        GRID_BAR();
        for (int i = vcu * 512 + tid; i < MS * DM / 8; i += G * 512) { f32x4 a0 = {0.f, 0.f, 0.f, 0.f}, a1 = a0;
#pragma unroll
            for (int k = 0; k < 8; ++k) { const v4u p = *(const v4u*)(SLAB + (size_t)k * (MS * DM) + (size_t)i * 8); a0 += (f32x4){bf_lo(p.x), bf_hi(p.x), bf_lo(p.y), bf_hi(p.y)}; a1 += (f32x4){bf_lo(p.z), bf_hi(p.z), bf_lo(p.w), bf_hi(p.w)}; }
            v4u w; w.x = cvt_pk_bf16(a0[0], a0[1]); w.y = cvt_pk_bf16(a0[2], a0[3]); w.z = cvt_pk_bf16(a1[0], a1[1]); w.w = cvt_pk_bf16(a1[2], a1[3]);
            *(v4u*)(MBUF + (size_t)MP * DM + (size_t)i * 8) = w; }
        if (BOTH(4)) GRID_BAR();
    }
    if (IN(5)) {
        pg8::Order S; S.init(MBUF, WOUT_T, MBUF, WOUT_T, DM, DM, MP, DM, DM, 1, G, bx, MS, 8, MP / 256); S.sub_first = bx & 1;
        pg8::EpiStore E{TB, DM, SLAB, MP / 256};
        pg8::gemm_phase<pg8::EpiStore>(lds + RING_OFF, S, E);
        if (BOTH(5)) GRID_BAR();
    }
    if (IN(6)) {
        f32x4 pg[8][2];
#pragma unroll
        for (int j = 0; j < 8; ++j) { const int c = (lane + 64 * j) * 8; pg[j][0] = *(const f32x4*)(post_g + c); pg[j][1] = *(const f32x4*)(post_g + c + 4); }
        const bool deal = (NGW == 2048); const int own_s = deal && gw < MS;
        const int r0 = deal ? (gw < MS ? gw * 5 : MS * 5 + (gw - MS) * 9) : gw, nrow = deal ? (gw < MS ? 6 : 9) : (M - gw + NGW - 1) / NGW;
        for (int j = 0; j < nrow; ++j) {
            const int m = deal ? ((own_s && j == 0) ? MP + gw : r0 + j - own_s) : gw + j * NGW;
            const float* xrow = m < MP ? x_prompt + (size_t)m * DM : x_sample + (size_t)(m - MP) * DM;
            f32x4 t0[8], t1[8], x0[8], x1[8]; float s = 0.f;
#pragma unroll
            for (int j = 0; j < 8; ++j) { const int c = (lane + 64 * j) * 8; x0[j] = *(const f32x4*)(xrow + c); x1[j] = *(const f32x4*)(xrow + c + 4); }
            if (m >= MP) {
#pragma unroll
                for (int j = 0; j < 8; ++j) { const int c = (lane + 64 * j) * 8; f32x4 a0 = {0.f, 0.f, 0.f, 0.f}, a1 = a0;
#pragma unroll
                    for (int k = 0; k < 8; ++k) { const v4u p = *(const v4u*)(SLAB + (size_t)k * (MS * DM) + (size_t)(m - MP) * DM + c); a0 += (f32x4){bf_lo(p.x), bf_hi(p.x), bf_lo(p.y), bf_hi(p.y)}; a1 += (f32x4){bf_lo(p.z), bf_hi(p.z), bf_lo(p.w), bf_hi(p.w)}; }
                    t0[j] = a0; t1[j] = a1; }
            } else {
                const v4u* tp = (const v4u*)(TB + (size_t)m * DM) + lane; v4u tw[8];
#pragma unroll
                for (int j = 0; j < 8; ++j) tw[j] = tp[64 * j];
#pragma unroll
                for (int j = 0; j < 8; ++j) { t0[j] = (f32x4){bf_lo(tw[j].x), bf_hi(tw[j].x), bf_lo(tw[j].y), bf_hi(tw[j].y)}; t1[j] = (f32x4){bf_lo(tw[j].z), bf_hi(tw[j].z), bf_lo(tw[j].w), bf_hi(tw[j].w)}; }
            }
#pragma unroll
            for (int j = 0; j < 8; ++j) { const f32x4 a0 = t0[j], a1 = t1[j]; s += (a0[0] * a0[0] + a0[1] * a0[1]) + (a0[2] * a0[2] + a0[3] * a0[3]) + (a1[0] * a1[0] + a1[1] * a1[1]) + (a1[2] * a1[2] + a1[3] * a1[3]); }
            const float r = 1.0f / sqrtf(wave_sum(s) * (1.f / DM) + EPS);
            float* yo = out + OFF_Y + (size_t)m * DM; v4u* xb = (v4u*)(X1B + (size_t)m * DM) + lane;
#pragma unroll
            for (int j = 0; j < 8; ++j) { const int c = (lane + 64 * j) * 8; const f32x4 y0 = x0[j] + t0[j] * r * pg[j][0], y1 = x1[j] + t1[j] * r * pg[j][1];
                if (m >= MP) { *(f32x4*)(yo + c) = y0; *(f32x4*)(yo + c + 4) = y1; }
                v4u w; w.x = cvt_pk_bf16(y0[0], y0[1]); w.y = cvt_pk_bf16(y0[2], y0[3]); w.z = cvt_pk_bf16(y1[0], y1[1]); w.w = cvt_pk_bf16(y1[2], y1[3]); xb[64 * j] = w; }
        }
        if (BOTH(6)) GRID_BAR();
    }
    if (IN(7)) {
        pg8::Order S; S.init(X1B, WPG_T, X1B, WPG_T, DM, DM, MP, DM, DM, 1, G, bx, MS, 8, MP / 256); S.sub_first = bx & 1;
        pg8::EpiFinal E{out + OFF_Y, PBUF, SLAB, MP / 256, X1B};
        pg8::gemm_phase<pg8::EpiFinal, false>(lds + RING_OFF, S, E);
        GRID_BAR();
        for (int i = vcu * 512 + tid; i < MS * DM / 4; i += G * 512) { f32x4 a = {0.f, 0.f, 0.f, 0.f};
#pragma unroll
            for (int k = 0; k < 8; ++k) { const v2u p = *(const v2u*)(SLAB + (size_t)k * (MS * DM) + (size_t)i * 4); a += (f32x4){bf_lo(p.x), bf_hi(p.x), bf_lo(p.y), bf_hi(p.y)}; }
            float* yp = out + OFF_Y + (size_t)MP * DM + (size_t)i * 4; const f32x4 x1 = *(const f32x4*)yp; const v2u p = *(const v2u*)(PBUF + (size_t)MP * DM + (size_t)i * 4);
            f32x4 y; y[0] = x1[0] + sigmoid_f(a[0]) * bf_lo(p.x); y[1] = x1[1] + sigmoid_f(a[1]) * bf_hi(p.x); y[2] = x1[2] + sigmoid_f(a[2]) * bf_lo(p.y); y[3] = x1[3] + sigmoid_f(a[3]) * bf_hi(p.y);
            *(f32x4*)yp = y; }
    }
#undef IN
#undef BOTH
#undef GRID_BAR
}

extern "C" void kernel_launch(void* const* d_in, const int* in_sizes, int n_in, void* d_out, int out_size, void* d_ws, size_t ws_size, hipStream_t stream) {
    static int grid = 0;
    if (grid == 0) {
        if (n_in != 19 || (size_t)out_size != OUT_TOTAL || ws_size < WS_END) { fprintf(stderr, "kernel_launch: unexpected shapes: n_in %d out %d ws %zu (need %zu)\n", n_in, out_size, ws_size, (size_t)WS_END); grid = -1; return; }
        int dev = 0, cus = 0, per_cu = 0;
        if (hipGetDevice(&dev) != hipSuccess || hipDeviceGetAttribute(&cus, hipDeviceAttributeMultiprocessorCount, dev) != hipSuccess) { grid = -1; return; }
        if (hipFuncSetAttribute((const void*)fwd_kernel, hipFuncAttributeMaxDynamicSharedMemorySize, LDS_BYTES) != hipSuccess) { fprintf(stderr, "kernel_launch: hipFuncSetAttribute failed\n"); grid = -1; return; }
        if (hipOccupancyMaxActiveBlocksPerMultiprocessor(&per_cu, (const void*)fwd_kernel, NWAVES * 64, LDS_BYTES) != hipSuccess || per_cu < 1)
            fprintf(stderr, "kernel_launch: note: occupancy query reports %d workgroups per CU\n", per_cu);
        (void)hipGetLastError();
        grid = cus;
    }
    if (grid < 0) return;
    if (hipMemsetAsync((char*)d_ws + WS_CTL, 0, CTL_ZERO_BYTES, stream) != hipSuccess) return;
    Args a{};
    for (int i = 0; i < 19; ++i) a.in[i] = (const float*)d_in[i];
    a.out = (float*)d_out; a.ws = (unsigned char*)d_ws;
    for (int li = 0; li < N_LAUNCHES; ++li) {
        a.ph_lo = (N_LAUNCHES == 1) ? 0 : li; a.ph_hi = (N_LAUNCHES == 1) ? N_PHASES : li + 1; a.li = li;
        hipLaunchKernelGGL(fwd_kernel, dim3(grid), dim3(NWAVES * 64), LDS_BYTES, stream, a);
        const hipError_t le = hipPeekAtLastError();
        if (le != hipSuccess) { fprintf(stderr, "kernel_launch: launch %d failed: %s\n", li, hipGetErrorName(le)); break; }
    }
}
```
